# Optimizing an MI355X kernel written in HIP

```python
import math
import jax
import jax.numpy as jnp
from jax import lax
import numpy as np


D_MODEL = 1024
BATCH = 32
SEQ = 2048
DEPTH = 2

HEAD_DIM = 64
N_HEADS_MOBA = 4
N_HEADS_DIFF = 4
DIFF_DIM = HEAD_DIM // 2
N_HEADS_FOX = 4
N_HEADS_DSA = 4
N_IDX_HEADS = 4
IDX_DIM = 64
BRANCH_WIDTH = 4 * HEAD_DIM
N_BRANCHES = 4
MOBA_BLOCK = 256
MOBA_TOPK = 3
MOBA_Q_CHUNK = 16
DSA_TOPK_MAX = 256
DSA_Q_CHUNK = 64
Q_BLOCK = 128
ROPE_THETA = 10000.0
N_EXPERTS = 256
TOP_K = 8
N_GROUPS = 8
TOPK_GROUPS = 4
EXPERT_DIM = 256
SHARED_DIM = 256
ROUTED_SCALE = 2.5
MOE_BLOCK = 128
LN_EPS = 1e-5
DEEPNORM_ALPHA = (2 * DEPTH) ** 0.25
DEEPNORM_BETA = (8 * DEPTH) ** -0.25

IN_SEGMENTS = (
    ('moba_q', BRANCH_WIDTH), ('moba_k', BRANCH_WIDTH), ('moba_v', BRANCH_WIDTH),
    ('diff_q', BRANCH_WIDTH), ('diff_k', BRANCH_WIDTH), ('diff_v', BRANCH_WIDTH),
    ('fox_q', BRANCH_WIDTH), ('fox_k', BRANCH_WIDTH), ('fox_v', BRANCH_WIDTH), ('fox_f', N_HEADS_FOX),
    ('dsa_q', BRANCH_WIDTH), ('dsa_k', BRANCH_WIDTH), ('dsa_v', BRANCH_WIDTH),
    ('idx_q', N_IDX_HEADS * IDX_DIM), ('idx_k', IDX_DIM), ('idx_w', N_IDX_HEADS),
    ('gates', N_BRANCHES * D_MODEL),
)

kernel_name = 'hybrid_moba_diff_fox_dsa_moe_deepnorm'

F32 = jnp.float32


def _normal(key, shape, scale):
    return jax.random.normal(key, shape, F32) * scale


def rope(x, pos):
    half = x.shape[-1] // 2
    inv_freq = ROPE_THETA ** (-jnp.arange(half, dtype=F32) / half)
    ang = pos.astype(F32)[:, None] * inv_freq[None, :]
    cos = jnp.cos(ang)[None, :, None, :].astype(x.dtype)
    sin = jnp.sin(ang)[None, :, None, :].astype(x.dtype)
    x1, x2 = x[..., :half], x[..., half:]
    return jnp.concatenate([x1 * cos - x2 * sin, x1 * sin + x2 * cos], axis=-1)


def layer_norm(x, g, b):
    xf = x.astype(F32)
    mu = jnp.mean(xf, axis=-1, keepdims=True)
    xc = xf - mu
    var = jnp.mean(xc * xc, axis=-1, keepdims=True)
    return (xc * lax.rsqrt(var + LN_EPS) * g.astype(F32) + b.astype(F32)).astype(x.dtype)


def split_projection(proj):
    parts = {}
    off = 0
    for name, width in IN_SEGMENTS:
        parts[name] = proj[..., off:off + width]
        off += width
    return parts


def moba_attention(q, k, v):
    B, T, H, d = q.shape
    nb = -(-T // MOBA_BLOCK)
    pad = nb * MOBA_BLOCK - T
    kp = jnp.pad(k, ((0, 0), (0, pad), (0, 0), (0, 0)))
    vp = jnp.pad(v, ((0, 0), (0, pad), (0, 0), (0, 0)))
    kb = kp.reshape(B, nb, MOBA_BLOCK, H, d).transpose(0, 3, 1, 2, 4)
    vb = vp.reshape(B, nb, MOBA_BLOCK, H, d).transpose(0, 3, 1, 2, 4)
    kmean = jnp.mean(kb.astype(F32), axis=3)
    n_sel = min(MOBA_TOPK, nb - 1)
    scale = d ** -0.5
    bi = jnp.arange(B)[:, None, None, None]
    hi = jnp.arange(H)[None, :, None, None]
    blk_ids = jnp.arange(nb)

    def chunk(i):
        s0 = i * MOBA_Q_CHUNK
        qc = lax.dynamic_slice_in_dim(q, s0, MOBA_Q_CHUNK, axis=1).transpose(0, 2, 1, 3)
        qpos = s0 + jnp.arange(MOBA_Q_CHUNK)
        cur = s0 // MOBA_BLOCK
        ko = lax.dynamic_index_in_dim(kb, cur, axis=2, keepdims=False)
        vo = lax.dynamic_index_in_dim(vb, cur, axis=2, keepdims=False)
        kpos_own = cur * MOBA_BLOCK + jnp.arange(MOBA_BLOCK)
        lo = jnp.einsum('bhqd,bhkd->bhqk', qc, ko, preferred_element_type=F32) * scale
        lo = jnp.where(kpos_own[None, :] <= qpos[:, None], lo, -jnp.inf)
        if n_sel == 0:
            p = jax.nn.softmax(lo, axis=-1)
            out = jnp.einsum('bhqk,bhkd->bhqd', p.astype(v.dtype), vo)
            return out.transpose(0, 2, 1, 3)
        gate = jnp.einsum('bhqd,bhnd->bhqn', qc.astype(F32), kmean)
        gate = jnp.where(blk_ids < cur, gate, -jnp.inf)
        gval, gidx = lax.top_k(gate, n_sel)
        ks = kb[bi, hi, gidx]
        vs = vb[bi, hi, gidx]
        ls = jnp.einsum('bhqd,bhqnkd->bhqnk', qc, ks, preferred_element_type=F32) * scale
        ls = jnp.where((gval > -jnp.inf)[..., None], ls, -jnp.inf)
        logits = jnp.concatenate([lo, ls.reshape(B, H, MOBA_Q_CHUNK, n_sel * MOBA_BLOCK)], axis=-1)
        p = jax.nn.softmax(logits, axis=-1).astype(v.dtype)
        po = p[..., :MOBA_BLOCK]
        ps = p[..., MOBA_BLOCK:].reshape(B, H, MOBA_Q_CHUNK, n_sel, MOBA_BLOCK)
        out = jnp.einsum('bhqk,bhkd->bhqd', po, vo) + jnp.einsum('bhqnk,bhqnkd->bhqd', ps, vs)
        return out.transpose(0, 2, 1, 3)

    o = lax.map(chunk, jnp.arange(T // MOBA_Q_CHUNK))
    return o.transpose(1, 0, 2, 3, 4).reshape(B, T, H * d)


def diff_attention(q, k, v, lam, subln_g, lambda_init):
    B, T, H, _, dd = q.shape
    scale = dd ** -0.5
    kpos = jnp.arange(T)

    def block(i):
        s0 = i * Q_BLOCK
        qb = lax.dynamic_slice_in_dim(q, s0, Q_BLOCK, axis=1)
        logits = jnp.einsum('bqhcd,bkhcd->bhcqk', qb, k, preferred_element_type=F32) * scale
        qpos = s0 + jnp.arange(Q_BLOCK)
        logits = jnp.where(kpos[None, :] <= qpos[:, None], logits, -jnp.inf)
        p = jax.nn.softmax(logits, axis=-1)
        a = p[:, :, 0] - lam * p[:, :, 1]
        return jnp.einsum('bhqk,bkhd->bqhd', a.astype(v.dtype), v)

    o = lax.map(block, jnp.arange(T // Q_BLOCK))
    o = o.transpose(1, 0, 2, 3, 4).reshape(B, T, H, 2 * dd).astype(F32)
    o = o * lax.rsqrt(jnp.mean(o * o, axis=-1, keepdims=True) + LN_EPS) * subln_g.astype(F32)
    return (o * (1.0 - lambda_init)).astype(v.dtype).reshape(B, T, H * 2 * dd)


def fox_attention(q, k, v, logf):
    B, T, H, d = q.shape
    scale = d ** -0.5
    c = jnp.cumsum(logf, axis=1).transpose(0, 2, 1)
    kpos = jnp.arange(T)

    def block(i):
        s0 = i * Q_BLOCK
        qb = lax.dynamic_slice_in_dim(q, s0, Q_BLOCK, axis=1)
        cb = lax.dynamic_slice_in_dim(c, s0, Q_BLOCK, axis=2)
        logits = jnp.einsum('bqhd,bkhd->bhqk', qb, k, preferred_element_type=F32) * scale
        logits = logits + (cb[..., :, None] - c[..., None, :])
        qpos = s0 + jnp.arange(Q_BLOCK)
        logits = jnp.where(kpos[None, :] <= qpos[:, None], logits, -jnp.inf)
        p = jax.nn.softmax(logits, axis=-1)
        return jnp.einsum('bhqk,bkhd->bqhd', p.astype(v.dtype), v)

    o = lax.map(block, jnp.arange(T // Q_BLOCK))
    return o.transpose(1, 0, 2, 3, 4).reshape(B, T, H * d)


def dsa_attention(q, k, v, qi, ki, wi):
    B, T, H, d = q.shape
    n_keep = min(DSA_TOPK_MAX, T // 4)
    scale = d ** -0.5
    kpos = jnp.arange(T)
    bi = jnp.arange(B)[:, None, None]

    def chunk(i):
        s0 = i * DSA_Q_CHUNK
        qc = lax.dynamic_slice_in_dim(q, s0, DSA_Q_CHUNK, axis=1)
        qic = lax.dynamic_slice_in_dim(qi, s0, DSA_Q_CHUNK, axis=1)
        wic = lax.dynamic_slice_in_dim(wi, s0, DSA_Q_CHUNK, axis=1).astype(F32) * N_IDX_HEADS ** -0.5
        qpos = s0 + jnp.arange(DSA_Q_CHUNK)
        dots = jnp.einsum('bqhd,bkd->bqhk', qic, ki, preferred_element_type=F32) * IDX_DIM ** -0.5
        score = jnp.einsum('bqh,bqhk->bqk', wic, jax.nn.relu(dots))
        score = jnp.where(kpos[None, :] <= qpos[:, None], score, -jnp.inf)
        sval, sidx = lax.top_k(score, n_keep)
        ks = k[bi, sidx]
        vs = v[bi, sidx]
        logits = jnp.einsum('bqhd,bqnhd->bhqn', qc, ks, preferred_element_type=F32) * scale
        logits = jnp.where((sval > -jnp.inf)[:, None], logits, -jnp.inf)
        p = jax.nn.softmax(logits, axis=-1)
        return jnp.einsum('bhqn,bqnhd->bqhd', p.astype(v.dtype), vs)

    o = lax.map(chunk, jnp.arange(T // DSA_Q_CHUNK))
    return o.transpose(1, 0, 2, 3, 4).reshape(B, T, H * d)


def token_mixer(x, w_in, b_forget, diff_lambda, diff_subln, w_branch, w_out, lambda_init):
    B, T, D = x.shape
    pos = jnp.arange(T)
    p = split_projection(jnp.einsum('btd,de->bte', x, w_in))

    def heads(a, h):
        return a.reshape(B, T, h, -1)

    o_a = moba_attention(rope(heads(p['moba_q'], N_HEADS_MOBA), pos),
                         rope(heads(p['moba_k'], N_HEADS_MOBA), pos),
                         heads(p['moba_v'], N_HEADS_MOBA))
    dq = rope(p['diff_q'].reshape(B, T, 2 * N_HEADS_DIFF, DIFF_DIM), pos).reshape(B, T, N_HEADS_DIFF, 2, DIFF_DIM)
    dk = rope(p['diff_k'].reshape(B, T, 2 * N_HEADS_DIFF, DIFF_DIM), pos).reshape(B, T, N_HEADS_DIFF, 2, DIFF_DIM)
    dl = diff_lambda.astype(F32)
    lam = jnp.exp(jnp.sum(dl[0] * dl[1])) - jnp.exp(jnp.sum(dl[2] * dl[3])) + lambda_init
    o_b = diff_attention(dq, dk, heads(p['diff_v'], N_HEADS_DIFF), lam, diff_subln, lambda_init)
    logf = jax.nn.log_sigmoid(p['fox_f'].astype(F32) + b_forget.astype(F32))
    o_c = fox_attention(heads(p['fox_q'], N_HEADS_FOX), heads(p['fox_k'], N_HEADS_FOX),
                        heads(p['fox_v'], N_HEADS_FOX), logf)
    qi = rope(p['idx_q'].reshape(B, T, N_IDX_HEADS, IDX_DIM), pos)
    ki = rope(p['idx_k'].reshape(B, T, 1, IDX_DIM), pos)[:, :, 0]
    o_d = dsa_attention(rope(heads(p['dsa_q'], N_HEADS_DSA), pos), rope(heads(p['dsa_k'], N_HEADS_DSA), pos),
                        heads(p['dsa_v'], N_HEADS_DSA), qi, ki, p['idx_w'])
    gates = jax.nn.sigmoid(p['gates']).reshape(B, T, N_BRANCHES, D)
    branches = (o_a, o_b, o_c, o_d)
    merged = gates[:, :, 0] * jnp.einsum('btc,cd->btd', branches[0], w_branch[0])
    for i in range(1, N_BRANCHES):
        merged = merged + gates[:, :, i] * jnp.einsum('btc,cd->btd', branches[i], w_branch[i])
    return jnp.einsum('btd,de->bte', merged, w_out)


def swiglu(x, w_gate, w_up, w_down):
    return (jax.nn.silu(x @ w_gate) * (x @ w_up)) @ w_down


def routed_experts(xf, eidx, wsel, w_gate, w_up, w_down):
    N, D = xf.shape
    E = w_gate.shape[0]
    A = N * TOP_K
    flat_e = eidx.reshape(A)
    flat_tok = jnp.arange(A) // TOP_K
    flat_w = wsel.reshape(A)
    order = jnp.argsort(flat_e)
    se, stok, sw = flat_e[order], flat_tok[order], flat_w[order]
    counts = jnp.bincount(flat_e, length=E)
    start = jnp.cumsum(counts) - counts
    padded = (counts + MOE_BLOCK - 1) // MOE_BLOCK * MOE_BLOCK
    pend = jnp.cumsum(padded)
    pstart = pend - padded
    dest = pstart[se] + (jnp.arange(A) - start[se])
    n_blocks = (A + E * (MOE_BLOCK - 1)) // MOE_BLOCK + 1
    P = n_blocks * MOE_BLOCK
    row_tok = jnp.full((P,), N, jnp.int32).at[dest].set(stok.astype(jnp.int32))
    row_w = jnp.zeros((P,), F32).at[dest].set(sw)
    block_e = jnp.minimum(jnp.searchsorted(pend, jnp.arange(n_blocks) * MOE_BLOCK, side='right'), E - 1)
    x_pad = jnp.concatenate([xf, jnp.zeros((1, D), xf.dtype)], axis=0)

    def body(b, acc):
        e = block_e[b]
        tok = lax.dynamic_slice_in_dim(row_tok, b * MOE_BLOCK, MOE_BLOCK)
        wr = lax.dynamic_slice_in_dim(row_w, b * MOE_BLOCK, MOE_BLOCK).astype(xf.dtype)
        y = swiglu(x_pad[tok], w_gate[e], w_up[e], w_down[e])
        return acc.at[tok].add(y * wr[:, None])

    acc = lax.fori_loop(0, n_blocks, body, jnp.zeros((N + 1, D), xf.dtype))
    return acc[:N]


def moe_ffn(x, w_router, router_bias, w_exp_gate, w_exp_up, w_exp_down, w_sh_gate, w_sh_up, w_sh_down):
    B, T, D = x.shape
    N = B * T
    xf = x.reshape(N, D)
    scores = jax.nn.sigmoid(jnp.einsum('nd,de->ne', xf, w_router, preferred_element_type=F32))
    biased = scores + router_bias.astype(F32)
    per_group = N_EXPERTS // N_GROUPS
    group_score = jnp.sum(lax.top_k(biased.reshape(N, N_GROUPS, per_group), 2)[0], axis=-1)
    _, gsel = lax.top_k(group_score, TOPK_GROUPS)
    gmask = jnp.any(gsel[..., None] == jnp.arange(N_GROUPS), axis=1)
    masked = jnp.where(jnp.repeat(gmask, per_group, axis=1), biased, -jnp.inf)
    _, eidx = lax.top_k(masked, TOP_K)
    wsel = jnp.take_along_axis(scores, eidx, axis=-1)
    wsel = wsel / jnp.sum(wsel, axis=-1, keepdims=True) * ROUTED_SCALE
    routed = routed_experts(xf, eidx, wsel, w_exp_gate, w_exp_up, w_exp_down)
    shared = swiglu(xf, w_sh_gate, w_sh_up, w_sh_down)
    return (routed + shared).reshape(B, T, D)


def setup_inputs(seed: int = 0) -> dict:
    key = jax.random.key(seed)
    ks = jax.random.split(key, 20)
    D, E, F, FS = D_MODEL, N_EXPERTS, EXPERT_DIM, SHARED_DIM
    x = jax.random.normal(ks[0], (BATCH, SEQ, D), F32)
    seg_keys = jax.random.split(ks[1], len(IN_SEGMENTS))
    cols = []
    for (name, width), k in zip(IN_SEGMENTS, seg_keys):
        s = D ** -0.5 * (DEEPNORM_BETA if name.endswith('_v') else 1.0)
        cols.append(_normal(k, (DEPTH, D, width), s))
    w_in = jnp.concatenate(cols, axis=-1)
    b_forget = 2.0 + _normal(ks[2], (DEPTH, N_HEADS_FOX), 0.5)
    diff_lambda = _normal(ks[3], (DEPTH, 4, DIFF_DIM), 0.1)
    diff_subln = 1.0 + _normal(ks[4], (DEPTH, 2 * DIFF_DIM), 0.02)
    w_branch = _normal(ks[5], (DEPTH, N_BRANCHES, BRANCH_WIDTH, D), BRANCH_WIDTH ** -0.5)
    w_out = _normal(ks[6], (DEPTH, D, D), D ** -0.5 * DEEPNORM_BETA)
    ln1_g = 1.0 + _normal(ks[7], (DEPTH, D), 0.02)
    ln1_b = _normal(ks[8], (DEPTH, D), 0.02)
    w_router = _normal(ks[9], (DEPTH, D, E), D ** -0.5)
    router_bias = _normal(ks[10], (DEPTH, E), 0.01)
    w_exp_gate = _normal(ks[11], (DEPTH, E, D, F), D ** -0.5 * DEEPNORM_BETA)
    w_exp_up = _normal(ks[12], (DEPTH, E, D, F), D ** -0.5 * DEEPNORM_BETA)
    w_exp_down = _normal(ks[13], (DEPTH, E, F, D), F ** -0.5 * DEEPNORM_BETA)
    w_sh_gate = _normal(ks[14], (DEPTH, D, FS), D ** -0.5 * DEEPNORM_BETA)
    w_sh_up = _normal(ks[15], (DEPTH, D, FS), D ** -0.5 * DEEPNORM_BETA)
    w_sh_down = _normal(ks[16], (DEPTH, FS, D), FS ** -0.5 * DEEPNORM_BETA)
    ln2_g = 1.0 + _normal(ks[17], (DEPTH, D), 0.02)
    ln2_b = _normal(ks[18], (DEPTH, D), 0.02)
    return {'x': x, 'w_in': w_in, 'b_forget': b_forget, 'diff_lambda': diff_lambda,
            'diff_subln': diff_subln, 'w_branch': w_branch, 'w_out': w_out,
            'ln1_g': ln1_g, 'ln1_b': ln1_b, 'w_router': w_router, 'router_bias': router_bias,
            'w_exp_gate': w_exp_gate, 'w_exp_up': w_exp_up, 'w_exp_down': w_exp_down,
            'w_sh_gate': w_sh_gate, 'w_sh_up': w_sh_up, 'w_sh_down': w_sh_down,
            'ln2_g': ln2_g, 'ln2_b': ln2_b}


def reference(x, w_in, b_forget, diff_lambda, diff_subln, w_branch, w_out, ln1_g, ln1_b,
              w_router, router_bias, w_exp_gate, w_exp_up, w_exp_down,
              w_sh_gate, w_sh_up, w_sh_down, ln2_g, ln2_b):
    for l in range(DEPTH):
        lambda_init = 0.8 - 0.6 * math.exp(-0.3 * l)
        h = token_mixer(x, w_in[l], b_forget[l], diff_lambda[l], diff_subln[l],
                        w_branch[l], w_out[l], lambda_init)
        x = layer_norm(DEEPNORM_ALPHA * x + h, ln1_g[l], ln1_b[l])
        h = moe_ffn(x, w_router[l], router_bias[l], w_exp_gate[l], w_exp_up[l], w_exp_down[l],
                    w_sh_gate[l], w_sh_up[l], w_sh_down[l])
        x = layer_norm(DEEPNORM_ALPHA * x + h, ln2_g[l], ln2_b[l])
    return x
```

```cpp
#include <hip/hip_runtime.h>
#include <cstdio>
#include <cstdint>

#ifndef MK_ONE_LAUNCH
#define MK_ONE_LAUNCH 1
#endif

#define GAS __attribute__((address_space(1)))
#define LAS __attribute__((address_space(3)))
typedef unsigned short bf16;
typedef short bf16x8 __attribute__((ext_vector_type(8)));
typedef short s16x4 __attribute__((ext_vector_type(4)));
typedef float f32x2 __attribute__((ext_vector_type(2)));
typedef float f32x4 __attribute__((ext_vector_type(4)));
typedef float f32x16 __attribute__((ext_vector_type(16)));
typedef unsigned u32x2 __attribute__((ext_vector_type(2)));
typedef unsigned u32x4 __attribute__((ext_vector_type(4)));
typedef __bf16 bf16x2_t __attribute__((ext_vector_type(2)));
typedef GAS unsigned gu32;

constexpr int NTOK = 65536, DM = 1024, SEQ = 2048, NBATCH = 32, NEXP = 256, EFF = 256;
constexpr int NWAVES = 8, NTHREADS = 512;
constexpr float LN_EPS = 1e-5f;
constexpr float ALPHA = 1.41421356237309515f;
constexpr float LOG2E = 1.4426950408889634f;
constexpr float H_SCALE = 16.0f;
constexpr float Y_SCALE = 32.0f;
constexpr int IN_NTILES = 30, IN_NCOLS = IN_NTILES * 256, IN_SRC = 7496;

constexpr size_t MiB = 1u << 20;
constexpr size_t WS_CTL = 0, CTL_BYTES = 1 * MiB;
constexpr size_t WS_CS64 = 1 * MiB;
constexpr size_t WS_CS32 = WS_CS64 + 512 * 1024;
constexpr size_t WS_KMEAN = WS_CS32 + 256 * 1024;
constexpr size_t WS_C2 = 2 * MiB;
constexpr size_t WS_LOGF = 3 * MiB;
constexpr size_t WS_IDXW = 4 * MiB;
constexpr size_t WS_EIDX = 5 * MiB;
constexpr size_t WS_WSEL = 7 * MiB;
constexpr size_t WS_SLOT = 9 * MiB;
constexpr size_t WS_DUMP = 12 * MiB;
constexpr size_t WS_IDENT = 11 * MiB;
constexpr size_t WS_DENSE = 16 * MiB, DENSE_L = 20 * MiB;
constexpr size_t DW_WG8 = 7 * MiB;
constexpr size_t DW_WIN = 0, DW_BR = 15 * MiB, DW_WO = 17 * MiB, DW_WR = 19 * MiB;
constexpr size_t AR = 56 * MiB;
constexpr size_t A_XB = AR + 0 * MiB;
constexpr size_t A_XB8 = AR + 128 * MiB;
constexpr size_t A_GATES = AR + 1480 * MiB;
constexpr size_t A_MERGED = AR + 784 * MiB;
constexpr size_t A_S = AR + 272 * MiB;
constexpr size_t A_MASK = AR + 1040 * MiB;
constexpr size_t A_TB = AR + 1056 * MiB;
constexpr size_t A_IDXK = A_TB + 416 * MiB;
constexpr size_t A_O = AR + 912 * MiB;
constexpr size_t A_PRE = AR + 386 * MiB;
constexpr size_t A_X1B = AR + 1736 * MiB;
constexpr size_t A_X1F8 = AR + 1864 * MiB;
constexpr size_t A_X1L = AR + 1552 * MiB;
constexpr size_t A_ROWL = AR + 1296 * MiB;
constexpr size_t A_SC = AR + 1360 * MiB;
constexpr size_t A_WEXP = AR + 0 * MiB;
constexpr size_t A_H = AR + 386 * MiB;
constexpr size_t A_Y = AR + 674 * MiB;
constexpr size_t WS_END = 2048 * MiB;
constexpr size_t WEXP_E = 1536 * 1024;
static_assert(A_WEXP + 257 * WEXP_E <= A_H && A_H + (size_t)(589824 + 256) * 512 <= A_Y + 1 * MiB && A_Y + (size_t)589824 * 2048 <= WS_END && A_GATES + 512 * MiB <= WS_END && A_IDXK + 8 * MiB <= A_GATES
              && A_S + 512 * MiB <= A_MERGED && A_S >= A_XB + 128 * MiB && A_WEXP + 257 * WEXP_E <= A_MERGED && A_SC + 64 * MiB <= A_GATES && A_PRE + 128 * MiB <= A_Y && A_GATES + 256 * MiB <= A_X1B && A_X1B + 128 * MiB <= A_X1F8 && A_X1F8 + 64 * MiB <= WS_END, "ws map");

constexpr int CW_TMO = 0, CW_BAR = 4096, CW_Q = 8192  , CW_CNT = 16384  ;

constexpr int RING_BYTES = 131072;
constexpr int LX_BASE = 155648;
constexpr int LX_MISC = LX_BASE;
constexpr int LX_TP = LX_BASE + 256;
constexpr int LX_ST = LX_TP + 1056;
constexpr int LX_LCNT = LX_ST + 1056;
constexpr int LX_LBASE = LX_LCNT + 1024;
constexpr int LDS_BYTES = 163840;
static_assert(LX_LBASE + 1024 <= LDS_BYTES, "lds map");

#define RLX_AGENT __ATOMIC_RELAXED, __HIP_MEMORY_SCOPE_AGENT
#define LDS_WAIT() asm volatile("s_waitcnt lgkmcnt(0)" ::: "memory")
#define VM_WAIT() asm volatile("s_waitcnt vmcnt(0)" ::: "memory")
__device__ __forceinline__ unsigned pk2(float lo, float hi) { f32x2 v = {lo, hi}; bf16x2_t b = __builtin_convertvector(v, bf16x2_t); return __builtin_bit_cast(unsigned, b); }
__device__ __forceinline__ float bflo(unsigned w) { return __uint_as_float(w << 16); }
__device__ __forceinline__ float bfhi(unsigned w) { return __uint_as_float(w & 0xffff0000u); }
__device__ __forceinline__ float wave_sum(float v) {
#pragma unroll
    for (int o = 1; o < 64; o <<= 1) v += __shfl_xor(v, o);
    return v;
}
__device__ __forceinline__ float sigmoidf_(float z) { return __builtin_amdgcn_rcpf(1.0f + __builtin_amdgcn_exp2f(-1.4426950408889634f * z)); }

#define XB_TMO      128
#define XB_XCNT(j)  (256  + 64 * (j))
#define XB_XSUB(j)  (1280 + 64 * (j))
#define XB_XGEN(j)  (2304 + 64 * (j))
#define XB_TOP      3328
#define XB_TOPGEN   3392
#define XCD_BAR_WORDS 3456
#define XB_SPIN_CAP (1u << 22)
__device__ __forceinline__ unsigned xb_ld(unsigned* p)              { return __hip_atomic_load(p, __ATOMIC_RELAXED, __HIP_MEMORY_SCOPE_AGENT); }
__device__ __forceinline__ unsigned xb_add(unsigned* p, unsigned v) { return __hip_atomic_fetch_add(p, v, __ATOMIC_RELAXED, __HIP_MEMORY_SCOPE_AGENT); }
__device__ __forceinline__ unsigned xb_xcc_id() { return (unsigned)__builtin_amdgcn_s_getreg((3 << 11) | 20) & 0xFu; }
#define XB_SPIN(cond, bar) do { unsigned _sp = 0; while (cond) { __builtin_amdgcn_s_sleep(1); \
    if ((++_sp & 255u) == 0u) { if (xb_ld(&(bar)[XB_TMO])) break; if (_sp > XB_SPIN_CAP) { atomicAdd(&(bar)[XB_TMO], 1u); break; } } } } while (0)
struct XcdBarrier { unsigned* bar; unsigned x; volatile LAS unsigned* st; };
__device__ __forceinline__ XcdBarrier xcd_barrier_post(unsigned* bar, volatile LAS unsigned* st) {
    XcdBarrier b; b.bar = bar; b.x = xb_xcc_id(); b.st = st;
    if (threadIdx.x == 0) (void)xb_add(&bar[XB_XCNT(b.x)], 1u);
    return b;
}
__device__ __forceinline__ void xcd_barrier_complete(unsigned* bar, unsigned x, unsigned& nloc, unsigned& nx) {
    const unsigned G = gridDim.x * gridDim.y * gridDim.z;
    unsigned sum, cnt, mine, sp = 0u;
    for (;;) {
        sum = 0u; cnt = 0u; mine = 0u;
#pragma unroll
        for (unsigned j = 0; j < 16; ++j) { const unsigned c = xb_ld(&bar[XB_XCNT(j)]); sum += c; cnt += (c > 0u) ? 1u : 0u; mine = (j == x) ? c : mine; }
        if (sum == G) break;
        __builtin_amdgcn_s_sleep(1);
        if ((++sp & 255u) == 0u) { if (xb_ld(&bar[XB_TMO])) break; if (sp > XB_SPIN_CAP) { atomicAdd(&bar[XB_TMO], 1u); break; } }
    }
    nloc = mine > 0u ? mine : 1u; nx = cnt > 0u ? cnt : 1u;
}
__device__ __forceinline__ void xcd_barrier(const XcdBarrier& b) {
    asm volatile("s_waitcnt vmcnt(0)" ::: "memory");
    __syncthreads();
    int t0_ = threadIdx.x; asm volatile("" : "+v"(t0_));
    if (t0_ == 0) {
        unsigned* bar = b.bar;
        __builtin_amdgcn_s_waitcnt(0);
        unsigned nloc = b.st[0], nx = b.st[1];
        if (nloc == 0u) { xcd_barrier_complete(bar, b.x, nloc, nx); b.st[0] = nloc; b.st[1] = nx; }
        const unsigned old = xb_add(&bar[XB_XSUB(b.x)], 1u);
        const unsigned gen = old / nloc;
        if (old + 1u == (gen + 1u) * nloc) {
            __builtin_amdgcn_fence(__ATOMIC_RELEASE, "agent");
            asm volatile("s_waitcnt vmcnt(0)" ::: "memory");
            const unsigned og = xb_add(&bar[XB_TOP], 1u);
            const unsigned tg = og / nx;
            if (og + 1u == (tg + 1u) * nx) xb_add(&bar[XB_TOPGEN], 1u);
            else XB_SPIN(xb_ld(&bar[XB_TOPGEN]) == tg, bar);
            __builtin_amdgcn_fence(__ATOMIC_ACQUIRE, "agent");
            xb_add(&bar[XB_XGEN(b.x)], 1u);
            asm volatile("s_waitcnt vmcnt(0)" ::: "memory");
        } else {
            XB_SPIN(xb_ld(&bar[XB_XGEN(b.x)]) == gen, bar);
            __builtin_amdgcn_fence(__ATOMIC_ACQUIRE, "agent");
            asm volatile("s_waitcnt vmcnt(0)" ::: "memory");
        }
    }
    __syncthreads();
}

namespace gm {
constexpr int BM = 256, BK = 64, HALF = 128, HTB = HALF * BK * 2, STAGE_BYTES = 8 * HTB;
__device__ __forceinline__ int lds_byte(int r, int c) { const int st = (r >> 4) * 2 + (c >> 5), rr = r & 15, cc = c & 31, ob = rr * 64 + cc * 2; return st * 1024 + (ob ^ (((ob >> 9) & 1) << 5)); }
__device__ __forceinline__ void stage_rc(int b, int& R, int& C) { const int st = b / 1024, sb = b % 1024, swz = sb ^ (((sb >> 9) & 1) << 5); R = (st >> 1) * 16 + swz / 64; C = (st & 1) * 32 + (swz % 64) / 2; }
__device__ __forceinline__ int perm32(int rho) { const int n = rho >> 4, i = rho & 15; return 8 * (i >> 2) + 4 * n + (i & 3); }

struct GUnit { const char* A; const char* B; int pm, pn, e, nrows, row0, seg; };

typedef int i32x8 __attribute__((ext_vector_type(8)));
typedef int i32x8a __attribute__((ext_vector_type(8), aligned(16)));
typedef int i32x4_ __attribute__((ext_vector_type(4)));
__device__ __forceinline__ i32x8 ld32(const LAS unsigned char* p) { const i32x4_ a = *(const LAS i32x4_*)p, b = *(const LAS i32x4_*)(p + 16); return __builtin_shufflevector(a, b, 0, 1, 2, 3, 4, 5, 6, 7); }
template <int K, bool GATHER, bool ALIGN_EPI, class Epi, class Sched, bool F8 = false, int SCALE_E8M0 = 0x7F7F7F7F, int SCALE_A = 0x7F7F7F7F, int RELAX = 0>
__device__ __forceinline__ void gemm_phase(LAS unsigned char* lds, const Sched& S, const Epi& E) {
    constexpr int ESZ = F8 ? 1 : 2;
    int tid_ = threadIdx.x; asm volatile("" : "+v"(tid_));
    const int tid = tid_, wid = __builtin_amdgcn_readfirstlane(tid >> 6), lane = tid & 63, wr = wid >> 2, wc = wid & 3, fr = lane & 15, fq = lane >> 4;
    constexpr int nt = K * ESZ / (BK * 2);
    static_assert(K % 128 == 0 && K >= 256 && nt % 2 == 0 && nt >= (F8 ? 2 : 4), "K");
    static_assert(RELAX == 0 || (RELAX == 8 && nt == 2 && F8 && !GATHER), "RELAX");
    const int swz_ = (lane * 16) ^ ((((lane * 16) >> 9) & 1) << 5), r4 = swz_ >> 6, cb_ = swz_ & 63;
    const int Rhi0 = (wid >> 1) * 16, cu_ = (wid & 1) * 64;
    auto rbf = [](int R) { return Epi::ADJ == 2 ? (64 * (R >> 5) + 16 * ((R & 15) >> 2) + 4 * ((R >> 4) & 1) + (R & 3))
                                : Epi::ADJ == 1 ? (64 * (R >> 5) + perm32(R & 31)) : (Epi::PERM ? ((R & ~31) + perm32(R & 31)) : R); };
    const unsigned laneB = (unsigned)(rbf(r4) * K * ESZ + cb_), laneA = (unsigned)(r4 * K * ESZ + cb_);
    unsigned uB[2], uA[2][2];
#pragma unroll
    for (int i = 0; i < 2; ++i) { uB[i] = (unsigned)__builtin_amdgcn_readfirstlane(rbf(Rhi0 + 64 * i) * K * ESZ + cu_);
#pragma unroll
        for (int h = 0; h < 2; ++h) uA[h][i] = (unsigned)__builtin_amdgcn_readfirstlane((h * HALF + Rhi0 + 64 * i) * K * ESZ + cu_); }
    constexpr size_t bhstep = Epi::ADJ == 2 ? (size_t)8 * K * ESZ : Epi::ADJ == 1 ? (size_t)32 * K * ESZ : (size_t)HALF * K * ESZ;
    constexpr size_t kstep = (size_t)(BK * 2);
    constexpr size_t hstep = (size_t)HALF * K * ESZ;
    const unsigned ldsw = (unsigned)wid * 1024u;
    const int aoff = F8 ? (wr * 8192 + (fq >> 1) * 1024 + fr * 64 + (((fq & 1) ^ (fr >> 3)) << 5)) : lds_byte(wr * 64 + fr, fq * 8);
    const int boff = F8 ? (wc * 4096 + (fq >> 1) * 1024 + fr * 64 + (((fq & 1) ^ (fr >> 3)) << 5)) : lds_byte(wc * 32 + fr, fq * 8);
#define PG8_SA(b, h) (((b) * 2 + (h)) * HTB)
#define PG8_SB(b, h) ((4 + (b) * 2 + (h)) * HTB)
#define PG8_GLDS(gptr, bufoff, _i) __builtin_amdgcn_global_load_lds((const unsigned*)(gptr), (LAS unsigned*)(lds + (bufoff) + ldsw + (_i) * 8192), 16, 0, 0)
#define PG8_STAGE_B(bufoff, gbase) do { _Pragma("unroll") for (int _i = 0; _i < 2; ++_i) PG8_GLDS((const char*)(gbase) + uB[_i] + laneB, bufoff, _i); } while (0)
#define PG8_STAGE_A(bufoff, gbase, h, NX) do { _Pragma("unroll") for (int _i = 0; _i < 2; ++_i) { \
        if constexpr (GATHER) PG8_GLDS((const char*)(gbase) + ((NX) ? nvo[h][_i] : cvo[h][_i]), bufoff, _i); else PG8_GLDS((const char*)(gbase) + uA[h][_i] + laneA, bufoff, _i); } } while (0)
#define PG8_LDA(dst, b, h) do { if constexpr (F8) { _Pragma("unroll") for (int m = 0; m < 4; ++m) dst##8[m] = ld32(lds + PG8_SA(b, h) + aoff + m * 2048); } \
        else { _Pragma("unroll") for (int m = 0; m < 4; ++m) _Pragma("unroll") for (int k = 0; k < 2; ++k) dst[m][k] = *(const LAS bf16x8*)(lds + PG8_SA(b, h) + aoff + m * 2048 + k * 1024); } } while (0)
#define PG8_LDB(dst, b, h) do { if constexpr (F8) { _Pragma("unroll") for (int n = 0; n < 2; ++n) dst##8[n] = ld32(lds + PG8_SB(b, h) + boff + n * 2048); } \
        else { _Pragma("unroll") for (int n = 0; n < 2; ++n) _Pragma("unroll") for (int k = 0; k < 2; ++k) dst[n][k] = *(const LAS bf16x8*)(lds + PG8_SB(b, h) + boff + n * 2048 + k * 1024); } } while (0)
#define PG8_MMA(ai, bj, At, Bt) do { __builtin_amdgcn_s_setprio(1); \
        if constexpr (F8) { _Pragma("unroll") for (int m = 0; m < 4; ++m) _Pragma("unroll") for (int n = 0; n < 2; ++n) \
            asm volatile("s_nop 1\n\tv_mfma_scale_f32_16x16x128_f8f6f4 %0, %1, %2, %0, %3, %4 op_sel_hi:[0,0,0]" : "+v"(acc[ai][bj][m][n]) : "v"(Bt##8[n]), "v"(At##8[m]), "v"(sclB_), "v"(sclA_)); } \
        else { _Pragma("unroll") for (int m = 0; m < 4; ++m) _Pragma("unroll") for (int n = 0; n < 2; ++n) _Pragma("unroll") for (int k = 0; k < 2; ++k) \
            acc[ai][bj][m][n] = __builtin_amdgcn_mfma_f32_16x16x32_bf16(Bt[n][k], At[m][k], acc[ai][bj][m][n], 0, 0, 0); } \
        __builtin_amdgcn_s_setprio(0); } while (0)
#define PG8_WAIT_V(n) asm volatile("s_waitcnt vmcnt(" #n ")" ::: "memory")
#define PG8_WAIT_L(n) asm volatile("s_waitcnt lgkmcnt(" #n ")" ::: "memory")
#define PG8_WAIT_RLX do { if constexpr (RELAX == 8) { if (ui == 0) PG8_WAIT_V(8); else PG8_WAIT_V(16); } else PG8_WAIT_V(8); } while (0)
#define PG8_BAR __builtin_amdgcn_s_barrier()
#define PG8_SCHED __builtin_amdgcn_sched_barrier(0)
  \
#define PG8_SETVO(vo, u) do { int _t[2][2]; unsigned _c2[2]; _Pragma("unroll") for (int _i = 0; _i < 2; ++_i) { int _R, _C; stage_rc(tid * 16 + _i * 8192, _R, _C); _c2[_i] = (unsigned)_C * 2u; \
            _Pragma("unroll") for (int _h = 0; _h < 2; ++_h) _t[_h][_i] = S.rowtok(u, _h * HALF + _R); } \
        asm volatile("" : "+v"(_t[0][0]), "+v"(_t[0][1]), "+v"(_t[1][0]), "+v"(_t[1][1])); \
        _Pragma("unroll") for (int _i = 0; _i < 2; ++_i) _Pragma("unroll") for (int _h = 0; _h < 2; ++_h) vo[_h][_i] = (unsigned)_t[_h][_i] * (unsigned)(K * ESZ) + _c2[_i]; } while (0)
    int sclB_ = SCALE_E8M0, sclA_ = SCALE_A; asm volatile("" : "+v"(sclB_), "+v"(sclA_));
    GUnit cur, nxt; int ui = 0;
    if (!S.next(0, cur)) return;
    f32x4 acc[2][2][4][2];
#pragma unroll
    for (int a = 0; a < 2; ++a)
#pragma unroll
        for (int b = 0; b < 2; ++b)
#pragma unroll
            for (int m = 0; m < 4; ++m)
#pragma unroll
                for (int n = 0; n < 2; ++n) acc[a][b][m][n] = (f32x4){0.f, 0.f, 0.f, 0.f};
    bf16x8 At[4][2], B0[2][2], B1[2][2]; i32x8 At8[4], B08[2], B18[2];
    unsigned cvo[2][2], nvo[2][2];
    if constexpr (GATHER) { PG8_SETVO(cvo, cur); }
    const char* cA = cur.A; const char* cB = cur.B;
#define PG8_KOFF(rot_, tt_) ((size_t)(((tt_) + (rot_)) & (nt - 1)) * kstep)
    auto krot = [](const GUnit& u) { return (u.pm + u.pn + u.e) & (nt - 1); };
    int crot = krot(cur), nrot = 0;
    { const size_t k0_ = PG8_KOFF(crot, 0); PG8_STAGE_B(PG8_SB(0, 0), cB + k0_); PG8_STAGE_B(PG8_SB(0, 1), cB + bhstep + k0_); PG8_STAGE_A(PG8_SA(0, 0), cA + k0_, 0, false); PG8_STAGE_A(PG8_SA(0, 1), cA + k0_, 1, false); }
    if (wr == 1) PG8_BAR;
    PG8_WAIT_V(2); PG8_BAR;
    { const size_t k1_ = PG8_KOFF(crot, 1); PG8_STAGE_B(PG8_SB(1, 0), cB + k1_); PG8_STAGE_A(PG8_SA(1, 0), cA + k1_, 0, false); PG8_STAGE_B(PG8_SB(1, 1), cB + bhstep + k1_); }
    PG8_WAIT_V(6); PG8_BAR;
    for (;;) {
        const bool has_next = S.next(ui + 1, nxt);
        const char* nA = has_next ? nxt.A : cA; const char* nB = has_next ? nxt.B : cB; nrot = has_next ? krot(nxt) : crot;
        if constexpr (GATHER) {
            if (has_next) { PG8_SETVO(nvo, nxt); }
            else {
#pragma unroll
                for (int h = 0; h < 2; ++h)
#pragma unroll
                    for (int i = 0; i < 2; ++i) nvo[h][i] = cvo[h][i];
            }
        }
#pragma unroll 1
        for (int t = 0; t < nt; t += 2) {
            const bool last = (t == nt - 2);
            const char* a1 = cA + PG8_KOFF(crot, t + 1);
            const size_t k2_ = last ? PG8_KOFF(nrot, 0) : PG8_KOFF(crot, t + 2), k3_ = last ? PG8_KOFF(nrot, 1) : PG8_KOFF(crot, t + 3);
            const char* a2 = (last ? nA : cA) + k2_; const char* b2 = (last ? nB : cB) + k2_;
            const char* a3 = (last ? nA : cA) + k3_; const char* b3 = (last ? nB : cB) + k3_;
            PG8_LDB(B0, 0, 0); PG8_LDB(B1, 0, 1); PG8_SCHED; PG8_LDA(At, 0, 0); PG8_STAGE_A(PG8_SA(1, 1), a1, 1, false);
            PG8_WAIT_RLX; PG8_WAIT_L(0); PG8_BAR; PG8_MMA(0, 0, At, B0); PG8_MMA(0, 1, At, B1); PG8_BAR; PG8_SCHED;
            PG8_LDA(At, 0, 1); PG8_STAGE_B(PG8_SB(0, 0), b2); PG8_STAGE_B(PG8_SB(0, 1), b2 + bhstep); PG8_STAGE_A(PG8_SA(0, 0), a2, 0, last);
            PG8_WAIT_RLX; PG8_WAIT_L(0); PG8_BAR; PG8_MMA(1, 0, At, B0); PG8_MMA(1, 1, At, B1); PG8_BAR; PG8_SCHED;
            PG8_LDB(B0, 1, 0); PG8_LDB(B1, 1, 1); PG8_SCHED; PG8_LDA(At, 1, 0); PG8_STAGE_A(PG8_SA(0, 1), a2, 1, last);
            PG8_WAIT_V(8); PG8_WAIT_L(0); PG8_BAR; PG8_MMA(0, 0, At, B0); PG8_MMA(0, 1, At, B1); PG8_BAR; PG8_SCHED;
            PG8_LDA(At, 1, 1); PG8_STAGE_B(PG8_SB(1, 0), b3); PG8_STAGE_B(PG8_SB(1, 1), b3 + bhstep); PG8_STAGE_A(PG8_SA(1, 0), a3, 0, last);
            PG8_WAIT_V(8); PG8_WAIT_L(0); PG8_BAR; PG8_MMA(1, 0, At, B0); PG8_MMA(1, 1, At, B1); PG8_BAR; PG8_SCHED;
        }
        if constexpr (ALIGN_EPI) { if (wr == 0) PG8_BAR; }
        if constexpr (F8) { asm volatile("s_nop 15\n\ts_nop 15" ::: "memory"); PG8_SCHED; }
        E(acc, cur, wr, wc, fr, fq);
        if (!has_next) break;
        if (!E.keep(nxt)) {
#pragma unroll
            for (int a = 0; a < 2; ++a)
#pragma unroll
                for (int b = 0; b < 2; ++b)
#pragma unroll
                    for (int m = 0; m < 4; ++m)
#pragma unroll
                        for (int n = 0; n < 2; ++n) acc[a][b][m][n] = (f32x4){0.f, 0.f, 0.f, 0.f};
        }
        cur = nxt; cA = nA; cB = nB; crot = nrot; ++ui;
        if constexpr (GATHER) {
#pragma unroll
            for (int h = 0; h < 2; ++h)
#pragma unroll
                for (int i = 0; i < 2; ++i) cvo[h][i] = nvo[h][i];
        }
        if constexpr (ALIGN_EPI) { if (wr == 1) PG8_BAR; }
    }
    PG8_WAIT_V(0);
    if constexpr (!ALIGN_EPI) { if (wr == 0) PG8_BAR; }
    PG8_BAR;
#undef PG8_SA
#undef PG8_SB
#undef PG8_STAGE_A
#undef PG8_STAGE_B
#undef PG8_GLDS
#undef PG8_LDA
#undef PG8_LDB
#undef PG8_MMA
#undef PG8_WAIT_V
#undef PG8_WAIT_L
#undef PG8_WAIT_RLX
#undef PG8_KOFF
#undef PG8_BAR
#undef PG8_SCHED
#undef PG8_SETVO
}

template <int K> struct GridOrder {
    const char* A; const char* Bt; int nM, nN, nwg, G, c;
    __device__ __forceinline__ void init(const void* A_, const void* Bt_, int nM_, int nN_, int G_, int c_) { A = (const char*)A_; Bt = (const char*)Bt_; nM = nM_; nN = nN_; nwg = nM * nN; G = G_; c = c_; }
    __device__ __forceinline__ bool next(int i, GUnit& u) const {
        const long L = (long)i * G + c; if (L >= nwg) return false;
        int wgid = (int)L; { const int q = nwg / 8, r = nwg % 8, xcd = wgid % 8, off = wgid / 8; wgid = (xcd < r ? xcd * (q + 1) : r * (q + 1) + (xcd - r) * q) + off; }
        const int nig = 8 * nN, gid = wgid / nig, fm = gid * 8, gsz = (nM - fm) < 8 ? (nM - fm) : 8;
        u.pm = fm + ((wgid % nig) % gsz); u.pn = (wgid % nig) / gsz; u.e = 0; u.nrows = 256; u.row0 = u.pm * 256; u.seg = 0;
        u.A = A + (size_t)u.pm * (256 * K * 2); u.B = Bt + (size_t)u.pn * (256 * K * 2); return true;
    }
    __device__ __forceinline__ unsigned rowoff(const GUnit&, int r) const { return (unsigned)(r * K * 2); }
};
template <int K> struct GridOrder8 {
    const char* A; const char* Bt; int nM, nN, nwg, G, c;
    __device__ __forceinline__ void init(const void* A_, const void* Bt_, int nM_, int nN_, int G_, int c_) { A = (const char*)A_; Bt = (const char*)Bt_; nM = nM_; nN = nN_; nwg = nM * nN; G = G_; c = c_; }
    __device__ __forceinline__ bool next(int i, GUnit& u) const {
        const long L = (long)i * G + c; if (L >= nwg) return false;
        int wgid = (int)L; { const int q = nwg / 8, r = nwg % 8, xcd = wgid % 8, off = wgid / 8; wgid = (xcd < r ? xcd * (q + 1) : r * (q + 1) + (xcd - r) * q) + off; }
        const int nig = 8 * nN, gid = wgid / nig, fm = gid * 8, gsz = (nM - fm) < 8 ? (nM - fm) : 8;
        u.pm = fm + ((wgid % nig) % gsz); u.pn = (wgid % nig) / gsz; u.e = 0; u.nrows = 256; u.row0 = u.pm * 256; u.seg = 0;
        u.A = A + (size_t)u.pm * (256 * K); u.B = Bt + (size_t)u.pn * (256 * K); return true;
    }
    __device__ __forceinline__ unsigned rowoff(const GUnit&, int r) const { return (unsigned)(r * K); }
};
template <int K> struct PanelOrder {
    const char* A; const char* Bt; int pm, npn;
    __device__ __forceinline__ bool next(int i, GUnit& u) const {
        if (i >= npn) return false;
        u.pm = pm; u.pn = i; u.e = 0; u.nrows = 256; u.row0 = pm * 256; u.seg = 0;
        u.A = A + (size_t)pm * (256 * K * 2); u.B = Bt + (size_t)i * (256 * K * 2); return true;
    }
    __device__ __forceinline__ unsigned rowoff(const GUnit&, int r) const { return (unsigned)(r * K * 2); }
};
struct RouterOrder {
    const char* Xhi; const char* Xlo; const char* Whi; const char* Wlo; int pm, nseg;
    __device__ __forceinline__ bool next(int i, GUnit& u) const {
        if (i >= nseg) return false;
        u.pm = pm; u.pn = 0; u.e = 0; u.nrows = 256; u.row0 = pm * 256; u.seg = i;
        u.A = (i == 1 ? Xlo : Xhi) + (size_t)pm * (256 * 1024 * 2); u.B = (i == 2 ? Wlo : Whi); return true;
    }
    __device__ __forceinline__ unsigned rowoff(const GUnit&, int r) const { return (unsigned)(r * 1024 * 2); }
};
struct MergeOrder {
    const char* O[4]; const char* BrT; int G, c;
    __device__ __forceinline__ bool next(int i, GUnit& u) const {
        const int tile = c * 4 + (i >> 2); if (i >= 16 || tile >= 1024) return false;
        const int seg = i & 3; u.pm = tile >> 2; u.pn = tile & 3; u.seg = seg; u.e = 0; u.nrows = 256; u.row0 = u.pm * 256;
        const char* o = seg == 0 ? O[0] : seg == 1 ? O[1] : seg == 2 ? O[2] : O[3];
        u.A = o + (size_t)u.pm * (256 * 256 * 2); u.B = BrT + (size_t)seg * (1024 * 256 * 2) + (size_t)u.pn * (256 * 256 * 2); return true;
    }
    __device__ __forceinline__ unsigned rowoff(const GUnit&, int r) const { return (unsigned)(r * 256 * 2); }
};
template <int K, int NPN, bool E1, int ESZ = 2> struct ExpertOrder {
    const LAS int* tp; const LAS int* st; const int* rowl; const int* ident; const char* Abase; const char* W; int G, c;
    __device__ __forceinline__ bool next(int i, GUnit& u) const {
        const int ntile = __builtin_amdgcn_readfirstlane(tp[257]);
        const int total = ntile * NPN, R = (total + 7) >> 3, nW = G >> 3, pos = i * nW + (c >> 3);
        const int L = (c & 7) * R + pos;
        if (pos >= R || L >= total) return false;
        const int tile = L / NPN, pn = L % NPN;
        int lo = 0, hi = 256;
#pragma unroll
        for (int it = 0; it < 9; ++it) { const int mid = (lo + hi + 1) >> 1; if (tp[mid] <= tile) lo = mid; else hi = mid - 1; }
        const int e = __builtin_amdgcn_readfirstlane(lo), rb = __builtin_amdgcn_readfirstlane(tile - tp[lo]);
        const int cnt = __builtin_amdgcn_readfirstlane(st[e + 1] - st[e]);
        u.e = e; u.pm = rb; u.pn = pn; u.seg = 0; u.nrows = min(256, cnt - rb * 256); u.row0 = __builtin_amdgcn_readfirstlane(st[e]) + rb * 256;
        if (E1) { u.A = Abase; u.B = W + (size_t)e * WEXP_E + (size_t)pn * (256 * 1024 * ESZ); }
        else { u.A = Abase + (size_t)u.row0 * (256 * ESZ); u.B = W + (size_t)e * WEXP_E + (size_t)(512 * 1024 * 2) + (size_t)pn * (256 * 256 * ESZ); }
        return true;
    }
    __device__ __forceinline__ int rowtok(const GUnit& u, int r) const {
        const int rr = min(r, u.nrows - 1);
        const int* base = (u.e == 256) ? ident : rowl + (size_t)u.e * 65536;
        return base[u.pm * 256 + rr];
    }
    __device__ __forceinline__ unsigned rowoff(const GUnit& u, int r) const {
        if (!E1) return (unsigned)(r * K * ESZ);
        const int rr = min(r, u.nrows - 1);
        const int* base = (u.e == 256) ? ident : rowl + (size_t)u.e * 65536;
        const int tok = base[u.pm * 256 + rr];
        return (unsigned)tok * (unsigned)(K * ESZ);
    }
};
}

namespace ep {
using gm::GUnit;
struct InProj {
    static constexpr bool PERM = true; static constexpr int ADJ = 2;
    unsigned char* ws; const float* bforget;
    __device__ __forceinline__ bool keep(const GUnit&) const { return false; }
    __device__ __forceinline__ void operator()(f32x4 (&acc)[2][2][4][2], const GUnit& u, int wr, int wc, int fr, int fq) const {
        const int pn = u.pn;
        int mode = 0; float scale = 1.f; bf16* out; int ld = 256;
        const bool ktile = (pn < 12) && (pn % 3 == 1);
        if (pn < 12) { const int br = pn / 3, kind = pn % 3; const int slot = (kind == 0) ? br : 4 + 2 * br + (kind - 1);
            out = (bf16*)(ws + A_TB + (size_t)slot * (32 * MiB));
            if (kind < 2) mode = (br == 0 || br == 3) ? 1 : (br == 1 ? 2 : 0);
            if (kind == 0) scale = (br == 1) ? 0.17677669529663687f * LOG2E : 0.125f * LOG2E; }
        else if (pn == 12) { out = (bf16*)(ws + A_TB + (size_t)12 * (32 * MiB)); mode = 1; scale = 0.125f; }
        else if (pn == 13) { out = (bf16*)(ws + A_IDXK); mode = 4; ld = 64; }
        else { out = (bf16*)(ws + A_GATES) + (pn - 14) * 256; mode = 3; ld = 4096; }
        float irev[2][4];
#pragma unroll
        for (int bj = 0; bj < 2; ++bj) { const int c8 = wc * 64 + fq * 16 + bj * 8; const int j0 = (mode == 2) ? ((c8 & 31) >> 1) : ((c8 & 63) >> 1); const float ih = (mode == 2) ? (1.0f / 16.0f) : (1.0f / 32.0f);
#pragma unroll
            for (int jj = 0; jj < 4; ++jj) irev[bj][jj] = __builtin_amdgcn_exp2f(-(float)(j0 + jj) * ih * 13.287712379549449f) * 0.15915494309189535f; }
#pragma unroll
        for (int ai = 0; ai < 2; ++ai)
#pragma unroll
            for (int m = 0; m < 4; ++m) {
                const int row = u.pm * 256 + ai * 128 + wr * 64 + m * 16 + fr, pos = row & (SEQ - 1);
#pragma unroll
                for (int bj = 0; bj < 2; ++bj) {
                    const int c8 = wc * 64 + fq * 16 + bj * 8;
                    f32x4 v0 = acc[ai][bj][m][0], v1 = acc[ai][bj][m][1];
                    if (mode == 4) {
                        if (c8 == 64) {
                            const f32x4 bf = *(const f32x4*)bforget;
                            f32x4 lf;
#pragma unroll
                            for (int i = 0; i < 4; ++i) { const float z = v0[i] + bf[i]; lf[i] = fminf(z, 0.f) - log1pf(__expf(-fabsf(z))); }
                            *(f32x4*)(ws + WS_LOGF + (size_t)row * 16) = lf;
                            *(f32x4*)(ws + WS_IDXW + (size_t)row * 16) = v1 * 0.5f;
                        }
                        if (c8 >= 64) continue;
                    }
                    if (mode == 1 || mode == 2 || mode == 4) {
                        const float fp = (float)pos;
                        float cs[4], sn[4];
#pragma unroll
                        for (int jj = 0; jj < 4; ++jj) { const float rv = __builtin_amdgcn_fractf(fp * irev[bj][jj]); cs[jj] = __builtin_amdgcn_cosf(rv); sn[jj] = __builtin_amdgcn_sinf(rv); }
                        f32x4 a, b;
                        a[0] = v0[0] * cs[0] - v0[1] * sn[0]; a[1] = v0[0] * sn[0] + v0[1] * cs[0];
                        a[2] = v0[2] * cs[1] - v0[3] * sn[1]; a[3] = v0[2] * sn[1] + v0[3] * cs[1];
                        b[0] = v1[0] * cs[2] - v1[1] * sn[2]; b[1] = v1[0] * sn[2] + v1[1] * cs[2];
                        b[2] = v1[2] * cs[3] - v1[3] * sn[3]; b[3] = v1[2] * sn[3] + v1[3] * cs[3];
                        v0 = a; v1 = b;
                    } else if (mode == 3) {
#pragma unroll
                        for (int i = 0; i < 4; ++i) { v0[i] = fminf(fmaxf(v0[i], -60.f), 60.f); v1[i] = fminf(fmaxf(v1[i], -60.f), 60.f); }
                    }
                    if (mode == 3) {
                        int w0 = 0, w1 = 0;
                        w0 = __builtin_amdgcn_cvt_pk_fp8_f32(v0[0], v0[1], w0, false); w0 = __builtin_amdgcn_cvt_pk_fp8_f32(v0[2], v0[3], w0, true);
                        w1 = __builtin_amdgcn_cvt_pk_fp8_f32(v1[0], v1[1], w1, false); w1 = __builtin_amdgcn_cvt_pk_fp8_f32(v1[2], v1[3], w1, true);
                        *(u32x2*)((unsigned char*)(ws + A_GATES) + (size_t)row * 4096 + (pn - 14) * 256 + c8) = (u32x2){(unsigned)w0, (unsigned)w1};
                        continue;
                    }
                    v0 = v0 * scale; v1 = v1 * scale;
                    u32x4 w; w.x = pk2(v0[0], v0[1]); w.y = pk2(v0[2], v0[3]); w.z = pk2(v1[0], v1[1]); w.w = pk2(v1[2], v1[3]);
                    if (ktile) {
                        const size_t tix = ((size_t)(row >> 11) * 4 + (c8 >> 6)) * 32 + (pos >> 6);
                        *(u32x4*)(out + tix * 4096 + ((c8 & 63) >> 3) * 512 + (pos & 63) * 8) = w;
                    } else *(u32x4*)(out + (size_t)row * ld + c8) = w;
                }
            }
    }
};
struct InGate {
    static constexpr bool PERM = true; static constexpr int ADJ = 2;
    unsigned char* gates;
    __device__ __forceinline__ bool keep(const GUnit&) const { return false; }
    __device__ __forceinline__ void operator()(f32x4 (&acc)[2][2][4][2], const GUnit& u, int wr, int wc, int fr, int fq) const {
#pragma unroll
        for (int ai = 0; ai < 2; ++ai)
#pragma unroll
            for (int m = 0; m < 4; ++m) {
                const int row = u.pm * 256 + ai * 128 + wr * 64 + m * 16 + fr;
                int w[4];
#pragma unroll
                for (int bj = 0; bj < 2; ++bj)
#pragma unroll
                    for (int n = 0; n < 2; ++n) { f32x4 v = acc[ai][bj][m][n];
#pragma unroll
                        for (int i = 0; i < 4; ++i) v[i] = __builtin_amdgcn_fmed3f(v[i], -86.5f, 86.5f);
                        int t = 0; t = __builtin_amdgcn_cvt_pk_fp8_f32(v[0], v[1], t, false); t = __builtin_amdgcn_cvt_pk_fp8_f32(v[2], v[3], t, true); w[2 * bj + n] = t; }
                *(u32x4*)(gates + (size_t)row * 4096 + u.pn * 256 + wc * 64 + fq * 16) = (u32x4){(unsigned)w[0], (unsigned)w[1], (unsigned)w[2], (unsigned)w[3]};
            }
    }
};
struct Merge {
    static constexpr bool PERM = true; static constexpr int ADJ = 2;
    const unsigned char* gates; bf16* merged;
    __device__ __forceinline__ bool keep(const GUnit& nx) const { return nx.seg != 0; }
    __device__ __forceinline__ void operator()(f32x4 (&acc)[2][2][4][2], const GUnit& u, int wr, int wc, int fr, int fq) const {
        const int seg = u.seg;
        const int c16 = u.pn * 256 + wc * 64 + fq * 16;
        const unsigned char* gbase = gates + (size_t)(u.pm * 256 + wr * 64 + fr) * 4096 + seg * 1024 + c16;
        constexpr int GD = 3;
        u32x4 qa[GD], qb[GD], ga, gb;
#define MG_ROWOFF(g_) ((size_t)(((g_) >> 2) * 128 + ((g_) & 3) * 16) * 4096)
#pragma unroll
        for (int d = 0; d < GD; ++d) { qa[d] = *(const u32x4*)(gbase + MG_ROWOFF(d)); qb[d] = (seg < 3) ? *(const u32x4*)(gbase + MG_ROWOFF(d) + 1024) : qa[d]; }
#pragma unroll
        for (int g = 0; g < 8; ++g) {
            const int ai = g >> 2, m = g & 3;
            ga = qa[g % GD]; gb = qb[g % GD];
            if (g + GD < 8) { qa[g % GD] = *(const u32x4*)(gbase + MG_ROWOFF(g + GD)); qb[g % GD] = (seg < 3) ? *(const u32x4*)(gbase + MG_ROWOFF(g + GD) + 1024) : qa[g % GD]; }
            const int row = u.pm * 256 + ai * 128 + wr * 64 + m * 16 + fr;
#pragma unroll
            for (int bj = 0; bj < 2; ++bj) {
                const unsigned gx = bj ? ga.z : ga.x, gy = bj ? ga.w : ga.y, hx = bj ? gb.z : gb.x, hy = bj ? gb.w : gb.y;
                const f32x2 a0 = __builtin_amdgcn_cvt_pk_f32_fp8((int)gx, false), a1 = __builtin_amdgcn_cvt_pk_f32_fp8((int)gx, true), a2 = __builtin_amdgcn_cvt_pk_f32_fp8((int)gy, false), a3 = __builtin_amdgcn_cvt_pk_f32_fp8((int)gy, true);
                f32x4 r0 = {a0[0], a0[1], a1[0], a1[1]}, r1 = {a2[0], a2[1], a3[0], a3[1]};
#pragma unroll
                for (int i = 0; i < 4; ++i) { r0[i] = __builtin_amdgcn_rcpf(1.0f + __builtin_amdgcn_exp2f(r0[i])); r1[i] = __builtin_amdgcn_rcpf(1.0f + __builtin_amdgcn_exp2f(r1[i])); }
                if (seg < 3) {
                    const f32x2 b0 = __builtin_amdgcn_cvt_pk_f32_fp8((int)hx, false), b1 = __builtin_amdgcn_cvt_pk_f32_fp8((int)hx, true), b2 = __builtin_amdgcn_cvt_pk_f32_fp8((int)hy, false), b3 = __builtin_amdgcn_cvt_pk_f32_fp8((int)hy, true);
                    const f32x4 d0 = {b0[0], b0[1], b1[0], b1[1]}, d1 = {b2[0], b2[1], b3[0], b3[1]};
#pragma unroll
                    for (int i = 0; i < 4; ++i) { r0[i] = r0[i] * (1.0f + __builtin_amdgcn_exp2f(d0[i])); r1[i] = r1[i] * (1.0f + __builtin_amdgcn_exp2f(d1[i])); }
                    acc[ai][bj][m][0] = acc[ai][bj][m][0] * r0; acc[ai][bj][m][1] = acc[ai][bj][m][1] * r1;
                } else {
                    const f32x4 v0 = acc[ai][bj][m][0] * r0, v1 = acc[ai][bj][m][1] * r1;
                    u32x4 w; w.x = pk2(v0[0], v0[1]); w.y = pk2(v0[2], v0[3]); w.z = pk2(v1[0], v1[1]); w.w = pk2(v1[2], v1[3]);
                    *(u32x4*)(merged + (size_t)row * 1024 + c16 + 8 * bj) = w;
                }
            }
        }
#undef MG_ROWOFF
    }
};
struct OutPre {
    static constexpr bool PERM = true; static constexpr int ADJ = 1;
    const bf16* x; bf16* pre;
    __device__ __forceinline__ bool keep(const GUnit&) const { return false; }
    __device__ __forceinline__ void operator()(f32x4 (&acc)[2][2][4][2], const GUnit& u, int wr, int wc, int fr, int fq) const {
        const size_t base = (size_t)(u.pm * 256 + wr * 64 + fr) * 1024 + u.pn * 256 + wc * 64 + fq * 8;
        u32x4 nx[2], cx[2];
#pragma unroll
        for (int bj = 0; bj < 2; ++bj) nx[bj] = *(const u32x4*)(x + base + bj * 32);
#pragma unroll
        for (int g = 0; g < 8; ++g) {
            const int ai = g >> 2, m = g & 3;
            const size_t off = base + (size_t)(ai * 128 + m * 16) * 1024;
#pragma unroll
            for (int bj = 0; bj < 2; ++bj) cx[bj] = nx[bj];
            if (g < 7) { const size_t o2 = base + (size_t)(((g + 1) >> 2) * 128 + ((g + 1) & 3) * 16) * 1024;
#pragma unroll
                for (int bj = 0; bj < 2; ++bj) nx[bj] = *(const u32x4*)(x + o2 + bj * 32); }
#pragma unroll
            for (int bj = 0; bj < 2; ++bj) { const f32x4 v0 = (f32x4){bflo(cx[bj].x), bfhi(cx[bj].x), bflo(cx[bj].y), bfhi(cx[bj].y)} * ALPHA + acc[ai][bj][m][0],
                                                         v1 = (f32x4){bflo(cx[bj].z), bfhi(cx[bj].z), bflo(cx[bj].w), bfhi(cx[bj].w)} * ALPHA + acc[ai][bj][m][1];
                u32x4 w; w.x = pk2(v0[0], v0[1]); w.y = pk2(v0[2], v0[3]); w.z = pk2(v1[0], v1[1]); w.w = pk2(v1[2], v1[3]);
                *(u32x4*)(pre + off + bj * 32) = w; }
        }
    }
};
struct Router {
    static constexpr bool PERM = false; static constexpr int ADJ = 0;
    float* sc; int last;
    __device__ __forceinline__ bool keep(const GUnit& nx) const { return nx.seg != 0; }
    __device__ __forceinline__ void operator()(f32x4 (&acc)[2][2][4][2], const GUnit& u, int wr, int wc, int fr, int fq) const {
        if (u.seg != last) return;
#pragma unroll
        for (int ai = 0; ai < 2; ++ai)
#pragma unroll
            for (int m = 0; m < 4; ++m) {
                const size_t off = (size_t)(u.pm * 256 + ai * 128 + wr * 64 + m * 16 + fr) * 256 + wc * 32 + 4 * fq;
#pragma unroll
                for (int bj = 0; bj < 2; ++bj)
#pragma unroll
                    for (int n = 0; n < 2; ++n) { f32x4 v = acc[ai][bj][m][n];
#pragma unroll
                        for (int i = 0; i < 4; ++i) v[i] = sigmoidf_(v[i]);
                        *(f32x4*)(sc + off + bj * 128 + n * 16) = v; }
            }
    }
};
struct E1 {
    static constexpr bool PERM = true; static constexpr int ADJ = 2;
    bf16* H;
    __device__ __forceinline__ bool keep(const GUnit&) const { return false; }
    __device__ __forceinline__ void operator()(f32x4 (&acc)[2][2][4][2], const GUnit& u, int wr, int wc, int fr, int fq) const {
#pragma unroll
        for (int ai = 0; ai < 2; ++ai)
#pragma unroll
            for (int m = 0; m < 4; ++m) {
                const int r = ai * 128 + wr * 64 + m * 16 + fr;
                if (r < u.nrows) {
                    int w[2] = {0, 0};
#pragma unroll
                    for (int bj = 0; bj < 2; ++bj)
#pragma unroll
                        for (int n = 0; n < 2; ++n) { const f32x4 v = acc[ai][bj][m][n];
                            const float h0 = v[0] * sigmoidf_(v[0]) * v[1] * H_SCALE, h1 = v[2] * sigmoidf_(v[2]) * v[3] * H_SCALE;
                            if (n == 0) w[bj] = __builtin_amdgcn_cvt_pk_fp8_f32(h0, h1, w[bj], false); else w[bj] = __builtin_amdgcn_cvt_pk_fp8_f32(h0, h1, w[bj], true); }
                    *(u32x2*)((unsigned char*)H + (size_t)(u.row0 + r) * 256 + u.pn * 128 + wc * 32 + fq * 8) = (u32x2){(unsigned)w[0], (unsigned)w[1]};
                }
            }
    }
};
struct E2 {
    static constexpr bool PERM = true; static constexpr int ADJ = 2;
    bf16* Y; int off; unsigned char* dump;
    __device__ __forceinline__ bool keep(const GUnit&) const { return false; }
    __device__ __forceinline__ void operator()(f32x4 (&acc)[2][2][4][2], const GUnit& u, int wr, int wc, int fr, int fq) const {
#pragma unroll
        for (int ai = 0; ai < 2; ++ai)
#pragma unroll
            for (int m = 0; m < 4; ++m) {
                const int r = ai * 128 + wr * 64 + m * 16 + fr;
                {
                    int w[4];
#pragma unroll
                    for (int bj = 0; bj < 2; ++bj)
#pragma unroll
                        for (int n = 0; n < 2; ++n) { const f32x4 v = acc[ai][bj][m][n] * Y_SCALE; int t = 0;
                            t = __builtin_amdgcn_cvt_pk_fp8_f32(v[0], v[1], t, false); t = __builtin_amdgcn_cvt_pk_fp8_f32(v[2], v[3], t, true); w[2 * bj + n] = t; }
                    unsigned char* const dst = (r < u.nrows) ? (unsigned char*)Y + (size_t)(u.row0 + r) * 1024 : dump + (size_t)r * 1024;
                    *(u32x4*)(dst + u.pn * 256 + wc * 64 + fq * 16) = (u32x4){(unsigned)w[0], (unsigned)w[1], (unsigned)w[2], (unsigned)w[3]};
                }
            }
    }
};
}

namespace att {
constexpr int PITCH = 256, KVBLK = 64, SLOTB = 8192;
constexpr int NSLOT = 5;
constexpr int L_K = 0, L_V = NSLOT * SLOTB, L_WS = 2 * NSLOT * SLOTB, L_OST = L_WS + 2048, L_KM = L_OST + 8 * 4096, L_C2 = L_KM + 8192, L_END = L_C2 + 8192;
static_assert(L_END <= LX_BASE, "attention lds");
typedef LAS const char* lds_cptr;
__device__ __forceinline__ int crow(int r, int hi) { return (r & 3) + 8 * (r >> 2) + 4 * hi; }
__device__ __forceinline__ void cmask(f32x16& p0, f32x16& p1, int jb, int qrel, int hi) {
    const float NEG = -INFINITY; const int kb = 64 * jb + 4 * hi;
#pragma unroll
    for (int r = 0; r < 16; ++r) { const int kv = kb + (r & 3) + 8 * (r >> 2); if (kv > qrel) p0[r] = NEG; if (kv + 32 > qrel) p1[r] = NEG; }
}
__device__ __forceinline__ void glds16(const void* gsrc, unsigned lds_dst) { unsigned keep;
    asm volatile("s_mov_b32 %0, m0\n\ts_mov_b32 m0, %2\n\ts_nop 0\n\tglobal_load_lds_dwordx4 %1, off\n\ts_mov_b32 m0, %0" : "=&s"(keep) : "v"(gsrc), "s"(lds_dst) : "memory"); }
#define ATT_WAIT_BAR(N) asm volatile("s_waitcnt vmcnt(" #N ") lgkmcnt(0)\n\ts_barrier" ::: "memory")
template <int D0A, int D0B> __device__ __forceinline__ void qkt(f32x16& p0, f32x16& p1, lds_cptr Kslot, const bf16x8* qr, int r32, int hi, const f32x16& z) {
    const lds_cptr kb = Kslot + hi * 1024 + r32 * 16;
#pragma unroll
    for (int d0 = D0A; d0 < D0B; ++d0) {
        const bf16x8 b0 = *(const LAS bf16x8*)(kb + d0 * 2048);
        const bf16x8 b1 = *(const LAS bf16x8*)(kb + d0 * 2048 + 512);
        if (d0 == D0A) { p0 = __builtin_amdgcn_mfma_f32_32x32x16_bf16(b0, qr[d0], z, 0, 0, 0); p1 = __builtin_amdgcn_mfma_f32_32x32x16_bf16(b1, qr[d0], z, 0, 0, 0); }
        else { p0 = __builtin_amdgcn_mfma_f32_32x32x16_bf16(b0, qr[d0], p0, 0, 0, 0); p1 = __builtin_amdgcn_mfma_f32_32x32x16_bf16(b1, qr[d0], p1, 0, 0, 0); }
    }
}
__device__ __forceinline__ float rowmax(const f32x16& p0, const f32x16& p1) {
    float a = fmaxf(fmaxf(p0[0], p0[1]), p1[0]), b = fmaxf(fmaxf(p0[2], p0[3]), p1[1]); a = fmaxf(fmaxf(a, p1[2]), p1[3]);
#pragma unroll
    for (int r = 4; r < 16; r += 4) { a = fmaxf(fmaxf(a, p0[r]), p0[r + 1]); b = fmaxf(fmaxf(b, p0[r + 2]), p0[r + 3]); a = fmaxf(fmaxf(a, p1[r]), p1[r + 1]); b = fmaxf(fmaxf(b, p1[r + 2]), p1[r + 3]); }
    const float m = fmaxf(a, b);
    const auto rr = __builtin_amdgcn_permlane32_swap(__float_as_uint(m), __float_as_uint(m), false, false);
    return fmaxf(__uint_as_float(rr[0]), __uint_as_float(rr[1]));
}
struct VFrag { s16x4 lo[8], hi[8]; };
__device__ __forceinline__ void load_v(VFrag& v, int vb) {
#pragma unroll
    for (int d0 = 0; d0 < 2; ++d0)
#pragma unroll
        for (int ks = 0; ks < 4; ++ks) {
            asm volatile("ds_read_b64_tr_b16 %0,%1 offset:%c2" : "=&v"(v.lo[d0 * 4 + ks]) : "v"(vb), "i"(d0 * 4096 + ks * 1024) : "memory");
            asm volatile("ds_read_b64_tr_b16 %0,%1 offset:%c2" : "=&v"(v.hi[d0 * 4 + ks]) : "v"(vb), "i"(d0 * 4096 + ks * 1024 + 512) : "memory"); }
    asm volatile("s_waitcnt lgkmcnt(0)" ::: "memory");
    __builtin_amdgcn_sched_barrier(0);
}
#define ATT_PK(v, k) (bf16x8){v.lo[k][0], v.lo[k][1], v.lo[k][2], v.lo[k][3], v.hi[k][0], v.hi[k][1], v.hi[k][2], v.hi[k][3]}
__device__ __forceinline__ void pv_mm(f32x16* o, const VFrag& v, const u32x4& pw0, const u32x4& pw1, const u32x4& pw2, const u32x4& pw3) {
#pragma unroll
    for (int d0 = 0; d0 < 2; ++d0) {
        o[d0] = __builtin_amdgcn_mfma_f32_32x32x16_bf16(__builtin_bit_cast(bf16x8, pw0), ATT_PK(v, d0 * 4 + 0), o[d0], 0, 0, 0);
        o[d0] = __builtin_amdgcn_mfma_f32_32x32x16_bf16(__builtin_bit_cast(bf16x8, pw1), ATT_PK(v, d0 * 4 + 1), o[d0], 0, 0, 0);
        o[d0] = __builtin_amdgcn_mfma_f32_32x32x16_bf16(__builtin_bit_cast(bf16x8, pw2), ATT_PK(v, d0 * 4 + 2), o[d0], 0, 0, 0);
        o[d0] = __builtin_amdgcn_mfma_f32_32x32x16_bf16(__builtin_bit_cast(bf16x8, pw3), ATT_PK(v, d0 * 4 + 3), o[d0], 0, 0, 0);
    }
}
constexpr float THR = 8.0f;
__device__ __forceinline__ void softmax_tile(f32x16& p0, f32x16& p1, float& m, float mu, float& minit, float& l, f32x16* o, f32x16& negm, LAS float* wsf, int r32, int hi, u32x4& pw0, u32x4& pw1, u32x4& pw2, u32x4& pw3) {
    const float d = m - mu;
    if (__any(d != 0.f)) {
#pragma unroll
        for (int r = 0; r < 16; ++r) { p0[r] -= d; p1[r] -= d; } }
    const float rm = rowmax(p0, p1);
    const bool fin = rm > -INFINITY, fresh = fin && (minit == 0.f);
    if (__any(fresh || rm > THR)) {
        const float dl = fresh ? rm : (fin ? fmaxf(rm, 0.f) : 0.f);
        m += dl;
#pragma unroll
        for (int r = 0; r < 16; ++r) { p0[r] -= dl; p1[r] -= dl; }
        const float alpha = fresh ? 1.0f : __builtin_amdgcn_exp2f(-dl);
        l *= alpha;
        if (hi == 0) wsf[r32] = alpha;
        asm volatile("s_waitcnt lgkmcnt(0)" ::: "memory");
#pragma unroll
        for (int r = 0; r < 16; ++r) { const float f = wsf[crow(r, hi)]; o[0][r] *= f; o[1][r] *= f; }
        asm volatile("s_waitcnt lgkmcnt(0)" ::: "memory");
#pragma unroll
        for (int r = 0; r < 16; ++r) negm[r] = -m;
    }
    minit = fin ? 1.0f : minit;
    float s = 0.f;
#pragma unroll
    for (int r = 0; r < 16; ++r) { p0[r] = __builtin_amdgcn_exp2f(p0[r]); p1[r] = __builtin_amdgcn_exp2f(p1[r]); s += p0[r] + p1[r]; }
    l += s;
    pw0 = (u32x4){pk2(p0[0], p0[1]), pk2(p0[2], p0[3]), pk2(p0[4], p0[5]), pk2(p0[6], p0[7])};
    pw1 = (u32x4){pk2(p0[8], p0[9]), pk2(p0[10], p0[11]), pk2(p0[12], p0[13]), pk2(p0[14], p0[15])};
    pw2 = (u32x4){pk2(p1[0], p1[1]), pk2(p1[2], p1[3]), pk2(p1[4], p1[5]), pk2(p1[6], p1[7])};
    pw3 = (u32x4){pk2(p1[8], p1[9]), pk2(p1[10], p1[11]), pk2(p1[12], p1[13]), pk2(p1[14], p1[15])};
}
struct Aux { unsigned char* ws; const float* dlam; const float* subln; float lam_init; };
template <int MODE>
__device__ __forceinline__ void attn_unit(int b, int h, int qb, const Aux& ax, LAS unsigned char* lds) {
    constexpr int QS = MODE == 0 ? 0 : MODE == 1 ? 1 : MODE == 2 ? 2 : 3, KS = 4 + 2 * QS, VS = 5 + 2 * QS;
    const bf16* Q = (const bf16*)(ax.ws + A_TB + (size_t)QS * (32 * MiB)); const bf16* K = (const bf16*)(ax.ws + A_TB + (size_t)KS * (32 * MiB));
    const bf16* V = (const bf16*)(ax.ws + A_TB + (size_t)VS * (32 * MiB)); bf16* O = (bf16*)(ax.ws + A_O + (size_t)QS * (32 * MiB));
    int tid_ = threadIdx.x; asm volatile("" : "+v"(tid_));
    const int tid = tid_, lane = tid & 63, r32 = lane & 31, hi = lane >> 5; const int wid = __builtin_amdgcn_readfirstlane(tid >> 6);
    const long rowbase = (long)b * SEQ; const int q0 = qb * 256;
    const bf16* Qw = Q + (rowbase + q0 + wid * 32) * PITCH + h * 64;
    const bf16* Kh = K + rowbase * PITCH + h * 64, *Vh = V + rowbase * PITCH + h * 64;
    const unsigned lds0 = (unsigned)(uintptr_t)lds;
    LAS float* wsf = (LAS float*)(lds + L_WS) + wid * 64;
    const bf16* ksrc = K + (((size_t)b * 4 + h) * 32) * 4096 + wid * 512 + lane * 8;
    const bf16* vsrc = Vh + (long)(16 * (wid & 3) + (lane >> 2)) * PITCH + (wid >> 2) * 32 + (lane & 3) * 8;
    const unsigned kdst = lds0 + L_K + wid * 1024, vdst = lds0 + L_V + wid * 1024;
#define DMA_K(t, slot) glds16(ksrc + (long)(t) * 4096, (unsigned)__builtin_amdgcn_readfirstlane(kdst + (slot)))
#define DMA_V(t, slot) glds16(vsrc + (long)(t) * KVBLK * PITCH, (unsigned)__builtin_amdgcn_readfirstlane(vdst + (slot)))
    const int vb0 = (int)(lds0 + L_V) + ((lane >> 4) & 1) * 32 + (lane & 3) * 8 + (4 * hi + ((lane & 15) >> 2)) * 64;
    const lds_cptr Kbase = (lds_cptr)(lds + L_K);
    const int NT = (q0 + 256) / KVBLK;
    DMA_K(0, 0); DMA_V(0, 0); DMA_K(1, SLOTB); DMA_V(1, SLOTB); DMA_K(2, 2 * SLOTB); DMA_V(2, 2 * SLOTB); DMA_K(3, 3 * SLOTB); DMA_V(3, 3 * SLOTB);
    if (NT > 4) { DMA_K(4, 4 * SLOTB); DMA_V(4, 4 * SLOTB); }
    bf16x8 qr[4];
#pragma unroll
    for (int d0 = 0; d0 < 4; ++d0) qr[d0] = *(const bf16x8*)(&Qw[(long)r32 * PITCH + d0 * 16 + hi * 8]);
    const int qrel = wid * 32 + r32;
    unsigned allow = 0xffu;
    if (MODE == 0 && qb >= 4) {
        if (wid == 0) { const int n = lane & 7, c = lane >> 3;
            const u32x4 kv = *(const u32x4*)((const bf16*)(ax.ws + WS_KMEAN) + (((size_t)b * 4 + h) * 8 + n) * 64 + c * 8);
            *(LAS u32x4*)(lds + L_KM + c * 1024 + n * 16) = kv; }
        asm volatile("s_waitcnt lgkmcnt(0)\n\ts_barrier" ::: "memory");
        f32x16 g0, g1; { const f32x16 zz = {}; qkt<0, 4>(g0, g1, (lds_cptr)(lds + L_KM), qr, r32, hi, zz); }
        float own[4], oth[4], g[8];
#pragma unroll
        for (int i = 0; i < 4; ++i) { own[i] = g0[i]; oth[i] = __shfl_xor(own[i], 32); }
#pragma unroll
        for (int i = 0; i < 4; ++i) { g[i] = hi ? oth[i] : own[i]; g[4 + i] = hi ? own[i] : oth[i]; }
        allow = 0u;
#pragma unroll
        for (int n = 0; n < 8; ++n) { int rank = 0;
#pragma unroll
            for (int mm = 0; mm < 8; ++mm) { if (mm != n) rank += (mm < qb && (g[mm] > g[n] || (g[mm] == g[n] && mm < n))) ? 1 : 0; }
            if (n < qb && rank < 3) allow |= 1u << n; }
    }
    const unsigned long long* mrow = (MODE == 3) ? (const unsigned long long*)(ax.ws + A_MASK) + (size_t)(rowbase + q0 + qrel) * 32 : nullptr;
    LAS float* c2l = (LAS float*)(lds + L_C2);
    if (MODE == 2) {
        const float* c2h = (const float*)(ax.ws + WS_C2) + ((size_t)b * 4 + h) * SEQ;
        if (4 * tid < q0 + 256) *(LAS f32x4*)(c2l + 4 * tid) = *(const f32x4*)(c2h + 4 * tid);
    }
    float m0 = 0.f, l0 = 0.f, m1 = 0.f, l1 = 0.f, mi0 = 0.f, mi1 = 0.f, mu_c = 0.f;
    f32x16 o[2], o2[2], negm0 = f32x16{}; o[0] = f32x16{}; o[1] = f32x16{}; o2[0] = f32x16{}; o2[1] = f32x16{};
#define ATT_ACTIVE(t_) ({ const int bd_ = (t_) - (NT - 4); bool a_ = !(bd_ >= 0 && 64 * bd_ > 32 * wid + 31); if (MODE == 0 && a_ && bd_ < 0) a_ = __any((allow >> ((t_) >> 2)) & 1u) != 0; a_; })
#define ATT_MASKS(S0, S1, t_) do { const int bd_ = (t_) - (NT - 4); \
        if (MODE == 2) { const LAS f32x4* cp_ = (const LAS f32x4*)(c2l + (t_) * KVBLK + 4 * hi); f32x4 cb_[8]; \
            _Pragma("unroll") for (int j_ = 0; j_ < 8; ++j_) cb_[j_] = cp_[2 * j_]; \
            _Pragma("unroll") for (int r_ = 0; r_ < 16; ++r_) { S0[r_] -= cb_[(r_ >> 2)][r_ & 3]; S1[r_] -= cb_[4 + (r_ >> 2)][r_ & 3]; } } \
        if (MODE == 3) { const unsigned ml_ = (unsigned)mk_c >> (4 * hi), mh_ = (unsigned)(mk_c >> 32) >> (4 * hi); \
            _Pragma("unroll") for (int r_ = 0; r_ < 16; ++r_) { const int cb2_ = (r_ & 3) + 8 * (r_ >> 2); if (!((ml_ >> cb2_) & 1u)) S0[r_] = -INFINITY; if (!((mh_ >> cb2_) & 1u)) S1[r_] = -INFINITY; } } \
        else if (bd_ >= 0) cmask(S0, S1, bd_, qrel, hi); \
        if (MODE == 0 && bd_ < 0 && !((allow >> ((t_) >> 2)) & 1u)) { _Pragma("unroll") for (int r_ = 0; r_ < 16; ++r_) { S0[r_] = -INFINITY; S1[r_] = -INFINITY; } } } while (0)
#define ATT_SLOT(t_) ((int)((unsigned)(t_) % (unsigned)NSLOT) * SLOTB)
#define ATT_END2(t_) do { if ((t_) + 2 < NT) { ATT_WAIT_BAR(0); \
            if ((t_) + 5 < NT) { const int s5_ = ATT_SLOT((t_) + 5); DMA_K((t_) + 5, s5_); DMA_V((t_) + 5, s5_); } \
            if ((t_) + 6 < NT) { const int s6_ = ATT_SLOT((t_) + 6); DMA_K((t_) + 6, s6_); DMA_V((t_) + 6, s6_); } } } while (0)
    unsigned long long mk_c = 0ull, mk_n = 0ull;
    if (NT > 4) ATT_WAIT_BAR(4); else ATT_WAIT_BAR(2);
    bool act = ATT_ACTIVE(0);
    f32x16 sA0, sA1, sB0, sB1; u32x4 pa0, pa1, pa2, pa3, pb0, pb1, pb2, pb3;
    if (MODE == 3) mk_c = mrow[0];
    const f32x16 zz = {}; f32x16 ndum = {};
    if (MODE == 1) { if (act) qkt<0, 2>(sA0, sA1, Kbase, qr, r32, hi, zz); }
    else { if (act) qkt<0, 4>(sA0, sA1, Kbase, qr, r32, hi, negm0); }
#define ATT_STEP(C0, C1, N0, N1, t_) do { \
        const bool actn_ = ((t_) + 1 < NT) && ATT_ACTIVE((t_) + 1); const float mu_n_ = m0; \
        if (actn_) qkt<0, 4>(N0, N1, Kbase + ATT_SLOT((t_) + 1), qr, r32, hi, negm0); \
        if (MODE == 3) mk_n = ((t_) + 1 < NT) ? mrow[(t_) + 1] : 0ull; \
        __builtin_amdgcn_sched_barrier(0); \
        if (act) { ATT_MASKS(C0, C1, t_); softmax_tile(C0, C1, m0, mu_c, mi0, l0, o, negm0, wsf, r32, hi, pa0, pa1, pa2, pa3); \
            VFrag vf_; load_v(vf_, vb0 + ATT_SLOT(t_)); pv_mm(o, vf_, pa0, pa1, pa2, pa3); } \
        act = actn_; mk_c = mk_n; mu_c = mu_n_; } while (0)
    if (MODE != 1) {
        for (int t = 0; t < NT; t += 2) { ATT_STEP(sA0, sA1, sB0, sB1, t); ATT_STEP(sB0, sB1, sA0, sA1, t + 1); ATT_END2(t); }
    } else {
#define ATT_DSTEP(t_) do {                    \
            if (act) qkt<2, 4>(sB0, sB1, Kbase + ATT_SLOT(t_), qr, r32, hi, zz); \
            __builtin_amdgcn_sched_barrier(0); \
            if (act) { ATT_MASKS(sA0, sA1, t_); softmax_tile(sA0, sA1, m0, 0.f, mi0, l0, o, ndum, wsf, r32, hi, pa0, pa1, pa2, pa3); } \
            const bool actn_ = ((t_) + 1 < NT) && ATT_ACTIVE((t_) + 1); \
            if (actn_) qkt<0, 2>(sA0, sA1, Kbase + ATT_SLOT((t_) + 1), qr, r32, hi, zz); \
            __builtin_amdgcn_sched_barrier(0); \
            if (act) { ATT_MASKS(sB0, sB1, t_); softmax_tile(sB0, sB1, m1, 0.f, mi1, l1, o2, ndum, wsf, r32, hi, pb0, pb1, pb2, pb3); \
                VFrag vf_; load_v(vf_, vb0 + ATT_SLOT(t_)); pv_mm(o, vf_, pa0, pa1, pa2, pa3); pv_mm(o2, vf_, pb0, pb1, pb2, pb3); } \
            act = actn_; } while (0)
        for (int t = 0; t < NT; t += 2) { ATT_DSTEP(t); ATT_DSTEP(t + 1); ATT_END2(t); }
#undef ATT_DSTEP
    }
#undef ATT_SLOT
#undef ATT_END2
#undef ATT_STEP
#undef ATT_MASKS
#undef ATT_ACTIVE
    l0 += __shfl_xor(l0, 32);
    if (MODE == 1) l1 += __shfl_xor(l1, 32);
    if (hi == 0) { wsf[r32] = 1.0f / l0; if (MODE == 1) wsf[32 + r32] = 1.0f / l1; }
    asm volatile("s_waitcnt lgkmcnt(0)" ::: "memory");
    float lam = 0.f;
    if (MODE == 1) { float s1 = 0.f, s2 = 0.f;
        for (int i = 0; i < 32; ++i) { s1 += ax.dlam[i] * ax.dlam[32 + i]; s2 += ax.dlam[64 + i] * ax.dlam[96 + i]; }
        lam = __expf(s1) - __expf(s2) + ax.lam_init; }
    bf16* Ow = O + (rowbase + q0 + wid * 32) * PITCH + h * 64;
    {   LAS bf16* stg = (LAS bf16*)(lds + L_OST) + wid * 2048;
#pragma unroll
        for (int r = 0; r < 16; ++r) { const int orow = crow(r, hi); const float ra = wsf[orow];
            float rb = 0.f; if (MODE == 1) rb = wsf[32 + orow] * lam;
#pragma unroll
            for (int d0 = 0; d0 < 2; ++d0) { float v = o[d0][r] * ra; if (MODE == 1) v -= o2[d0][r] * rb;
                stg[orow * 64 + d0 * 32 + r32] = (bf16)(pk2(v, 0.f) & 0xffffu); } }
        asm volatile("s_waitcnt lgkmcnt(0)" ::: "memory");
#pragma unroll
        for (int i = 0; i < 4; ++i) { const int row = i * 8 + (lane >> 3), ch = lane & 7;
            u32x4 v = *(const LAS u32x4*)(stg + row * 64 + ch * 8);
            if (MODE == 1) {
                float x[8] = {bflo(v.x), bfhi(v.x), bflo(v.y), bfhi(v.y), bflo(v.z), bfhi(v.z), bflo(v.w), bfhi(v.w)};
                float ss = 0.f;
#pragma unroll
                for (int j = 0; j < 8; ++j) ss += x[j] * x[j];
                ss += __shfl_xor(ss, 1); ss += __shfl_xor(ss, 2); ss += __shfl_xor(ss, 4);
                const float rs = rsqrtf(ss * (1.0f / 64.0f) + LN_EPS) * (1.0f - ax.lam_init);
                const f32x4 ga = *(const f32x4*)(ax.subln + ch * 8), gb = *(const f32x4*)(ax.subln + ch * 8 + 4);
                v.x = pk2(x[0] * rs * ga[0], x[1] * rs * ga[1]); v.y = pk2(x[2] * rs * ga[2], x[3] * rs * ga[3]);
                v.z = pk2(x[4] * rs * gb[0], x[5] * rs * gb[1]); v.w = pk2(x[6] * rs * gb[2], x[7] * rs * gb[3]);
            }
            *(u32x4*)(Ow + (long)row * PITCH + ch * 8) = v; }
    }
    asm volatile("s_waitcnt lgkmcnt(0)\n\ts_barrier" ::: "memory");
#undef DMA_K
#undef DMA_V
}
}

template <int CTRL> __device__ __forceinline__ int dppi(int v) { return __builtin_amdgcn_update_dpp(0, v, CTRL, 0xf, 0xf, false); }
__device__ __forceinline__ int wave_sum_i(int v) {
    v += dppi<0xB1>(v); v += dppi<0x4E>(v); v += dppi<0x141>(v); v += dppi<0x140>(v);
    return __builtin_amdgcn_readlane(v, 0) + __builtin_amdgcn_readlane(v, 16) + __builtin_amdgcn_readlane(v, 32) + __builtin_amdgcn_readlane(v, 48);
}
namespace pre {
__device__ __forceinline__ void cumsum_task(int task, const float* logf, float* c2) {
    int tid_ = threadIdx.x; asm volatile("" : "+v"(tid_));
    const int lane = tid_ & 63, wid = tid_ >> 6;
    const int seq = task * 8 + wid, b = seq >> 2, h = seq & 3;
    const float* src = logf + ((size_t)b * SEQ + lane * 32) * 4 + h;
    float tot = 0.f;
    for (int i = 0; i < 32; ++i) tot += src[i * 4];
    float incl = tot;
#pragma unroll
    for (int off = 1; off < 64; off <<= 1) { const float n = __shfl_up(incl, off); if (lane >= off) incl += n; }
    float run = incl - tot;
    float* dst = c2 + ((size_t)b * 4 + h) * SEQ + lane * 32;
    for (int i = 0; i < 32; ++i) { run += src[i * 4]; dst[i] = run * LOG2E; }
}
__device__ __forceinline__ void kmean_task(int task, const bf16* K, bf16* kmean) {
    int tid_ = threadIdx.x; asm volatile("" : "+v"(tid_));
    const int lane = tid_ & 63, wid = tid_ >> 6;
    const int idx = task * 8 + wid, b = idx >> 5, h = (idx >> 3) & 3, n = idx & 7;
    const bf16* src = K + (((size_t)b * 4 + h) * 32 + n * 4) * 4096 + lane * 8;
    float s[8][8];
#pragma unroll
    for (int c = 0; c < 8; ++c)
#pragma unroll
        for (int d = 0; d < 8; ++d) s[c][d] = 0.f;
#pragma unroll
    for (int t = 0; t < 4; ++t)
#pragma unroll
        for (int c = 0; c < 8; ++c) { const u32x4 v = *(const u32x4*)(src + (size_t)t * 4096 + c * 512);
            s[c][0] += bflo(v.x); s[c][1] += bfhi(v.x); s[c][2] += bflo(v.y); s[c][3] += bfhi(v.y); s[c][4] += bflo(v.z); s[c][5] += bfhi(v.z); s[c][6] += bflo(v.w); s[c][7] += bfhi(v.w); }
    float mine = 0.f;
#pragma unroll
    for (int c = 0; c < 8; ++c)
#pragma unroll
        for (int d = 0; d < 8; ++d) { const float tsum = wave_sum(s[c][d]); if (lane == 8 * c + d) mine = tsum; }
    kmean[(size_t)idx * 64 + lane] = (bf16)(pk2(mine * (1.0f / 256.0f), 0.f) & 0xffffu);
}
__device__ __forceinline__ unsigned mono(float v) { const unsigned u = __float_as_uint(v); return (u & 0x80000000u) ? ~u : (u | 0x80000000u); }
__device__ __forceinline__ void d1_unit(int b, int j, const bf16* IQ, const bf16* IK, const float* IW, float* S, unsigned long long* MASK, LAS unsigned char* lds, int bmask = 7) {
    int tid_ = threadIdx.x; asm volatile("" : "+v"(tid_));
    const int tid = tid_, lane = tid & 63, r32 = lane & 31, hi = lane >> 5; const int wid = __builtin_amdgcn_readfirstlane(tid >> 6);
    const int q0 = 32 * j; const long rowbase = (long)b * SEQ;
    const int nt = (q0 + 32 + 63) >> 6;
    const bool need_sel = (q0 >= 256);
    if (need_sel && (bmask & 1)) {
        {   const u32x4 qv = *(const u32x4*)(IQ + (size_t)(rowbase + q0 + (tid >> 5)) * 256 + (tid & 31) * 8);
            *(LAS u32x4*)(lds + 98304 + (tid >> 5) * 528 + (tid & 31) * 16) = qv;
            const u32x4 qv2 = *(const u32x4*)(IQ + (size_t)(rowbase + q0 + 16 + (tid >> 5)) * 256 + (tid & 31) * 8);
            *(LAS u32x4*)(lds + 98304 + (16 + (tid >> 5)) * 528 + (tid & 31) * 16) = qv2; }
        const f32x4 w4 = *(const f32x4*)(IW + (size_t)(rowbase + q0 + r32) * 4);
        LDS_WAIT(); __syncthreads();
        const LAS unsigned char* qil = lds + 98304 + r32 * 528 + hi * 16;
        bf16x8 kn0[4], kn1[4];
        if (wid < nt) {
#pragma unroll
            for (int d0 = 0; d0 < 4; ++d0) { kn0[d0] = *(const bf16x8*)(IK + (size_t)(rowbase + 64 * wid + r32) * 64 + d0 * 16 + hi * 8);
                                             kn1[d0] = *(const bf16x8*)(IK + (size_t)(rowbase + 64 * wid + 32 + r32) * 64 + d0 * 16 + hi * 8); } }
        for (int t = wid; t < nt; t += 8) {
            const int kv0 = 64 * t;
            bf16x8 k0[4], k1[4];
#pragma unroll
            for (int d0 = 0; d0 < 4; ++d0) { k0[d0] = kn0[d0]; k1[d0] = kn1[d0]; }
            if (t + 8 < nt) {
#pragma unroll
                for (int d0 = 0; d0 < 4; ++d0) { kn0[d0] = *(const bf16x8*)(IK + (size_t)(rowbase + kv0 + 512 + r32) * 64 + d0 * 16 + hi * 8);
                                                 kn1[d0] = *(const bf16x8*)(IK + (size_t)(rowbase + kv0 + 544 + r32) * 64 + d0 * 16 + hi * 8); } }
            f32x16 s0 = {}, s1 = {};
#pragma unroll 1
            for (int hh = 0; hh < 4; ++hh) {
                bf16x8 qi[4];
#pragma unroll
                for (int d0 = 0; d0 < 4; ++d0) qi[d0] = *(const LAS bf16x8*)(qil + hh * 128 + d0 * 32);
                const float wh = hh == 0 ? w4[0] : hh == 1 ? w4[1] : hh == 2 ? w4[2] : w4[3];
                f32x16 p0 = {}, p1 = {};
#pragma unroll
                for (int d0 = 0; d0 < 4; ++d0) { p0 = __builtin_amdgcn_mfma_f32_32x32x16_bf16(k0[d0], qi[d0], p0, 0, 0, 0); p1 = __builtin_amdgcn_mfma_f32_32x32x16_bf16(k1[d0], qi[d0], p1, 0, 0, 0); }
#pragma unroll
                for (int r = 0; r < 16; ++r) { s0[r] = __builtin_fmaf(wh, __builtin_amdgcn_fmed3f(p0[r], 0.f, 3.0e38f), s0[r]); s1[r] = __builtin_fmaf(wh, __builtin_amdgcn_fmed3f(p1[r], 0.f, 3.0e38f), s1[r]); }
            }
            {   LAS float* stg = (LAS float*)(lds + wid * 8704);
                LAS float* wp = stg + r32 * 68 + 4 * hi;
#pragma unroll
                for (int jj = 0; jj < 4; ++jj) { *(LAS f32x4*)(wp + 8 * jj) = (f32x4){s0[4 * jj], s0[4 * jj + 1], s0[4 * jj + 2], s0[4 * jj + 3]};
                                                 *(LAS f32x4*)(wp + 32 + 8 * jj) = (f32x4){s1[4 * jj], s1[4 * jj + 1], s1[4 * jj + 2], s1[4 * jj + 3]}; }
                LDS_WAIT(); asm volatile("" ::: "memory");
                float* gp = S + (size_t)(rowbase + q0 + (lane >> 4)) * SEQ + kv0 + 4 * (lane & 15);
#pragma unroll
                for (int rr = 0; rr < 8; ++rr) *(f32x4*)(gp + (size_t)(4 * rr) * SEQ) = *(const LAS f32x4*)(stg + (4 * rr + (lane >> 4)) * 68 + 4 * (lane & 15));
                LDS_WAIT(); asm volatile("" ::: "memory"); }
        }
    }
    VM_WAIT(); __syncthreads();
    f32x4 svn[8];
    if (need_sel && (bmask & 2)) {
#pragma unroll
        for (int g = 0; g < 8; ++g) svn[g] = *(const f32x4*)(S + (size_t)(rowbase + q0 + 4 * wid) * SEQ + 256 * g + 4 * lane); }
    for (int i = 0; i < 4; ++i) {
        const int q = q0 + 4 * wid + i;
        const float* srow = S + (size_t)(rowbase + q) * SEQ;
        unsigned tkey = 0u, tik = 0u;
        unsigned key[32];
#define D1_KIDX(x) (256 * ((x) >> 2) + 4 * lane + ((x) & 3))
        if (need_sel && (bmask & 2)) {
            {
#pragma unroll
                for (int x = 0; x < 32; ++x) key[x] = (D1_KIDX(x) <= q) ? mono(svn[x >> 2][x & 3]) : 0u;
                if (i < 3) {
#pragma unroll
                    for (int g = 0; g < 8; ++g) svn[g] = *(const f32x4*)(srow + SEQ + 256 * g + 4 * lane); } }
            const int ng = (q >> 8) + 1;
#define D1_COUNT(dst, COND) do { int c_ = 0; \
                _Pragma("unroll") for (int g_ = 0; g_ < 8; ++g_) if (g_ < ng) { _Pragma("unroll") for (int cc_ = 0; cc_ < 4; ++cc_) { const int ch = g_ * 4 + cc_; c_ += (COND) ? 1 : 0; } } \
                dst = wave_sum_i(c_); } while (0)
            unsigned T = 0u; bool exact = false;
            for (int bit = 31; bit >= 0; --bit) {
                const unsigned cand = T | (1u << bit);
                int cnt; D1_COUNT(cnt, key[ch] >= cand);
                if (cnt >= 256) { T = cand; if (cnt == 256) { exact = true; break; } }
            }
            tkey = T;
            if (!exact) {
                int cg, ce; D1_COUNT(cg, key[ch] > T); D1_COUNT(ce, key[ch] == T);
                const int r = 256 - cg;
                if (ce != r) { unsigned I = 0u;
                    for (int bit = 10; bit >= 0; --bit) { const unsigned cand = I | (1u << bit); int cnt;
                        D1_COUNT(cnt, key[ch] == T && (2047u - (unsigned)D1_KIDX(ch)) >= cand);
                        if (cnt >= r) I = cand; }
                    tik = I; }
            }
#undef D1_COUNT
        } else {
#pragma unroll
            for (int x = 0; x < 32; ++x) key[x] = (D1_KIDX(x) <= q) ? 1u : 0u;
        }
        const int nchunk = (bmask & 4) ? 4 * (j >> 3) + 4 : 0;
        unsigned mlo = 0u, mhi = 0u;
#pragma unroll
        for (int g = 0; g < 8; ++g) {
            unsigned nib = 0u;
#pragma unroll
            for (int e = 0; e < 4; ++e) { const unsigned kk = key[4 * g + e], ik = 2047u - (unsigned)D1_KIDX(4 * g + e);
                nib |= ((kk != 0u) && ((kk > tkey) || (kk == tkey && ik >= tik))) ? (1u << e) : 0u; }
            const int sh = 4 * (lane & 15);
            int lo = (sh < 32) ? (int)(nib << sh) : 0, hi = (sh >= 32) ? (int)(nib << (sh - 32)) : 0;
            lo |= dppi<0xB1>(lo); hi |= dppi<0xB1>(hi); lo |= dppi<0x4E>(lo); hi |= dppi<0x4E>(hi);
            lo |= dppi<0x141>(lo); hi |= dppi<0x141>(hi); lo |= dppi<0x140>(lo); hi |= dppi<0x140>(hi);
            if ((lane & 15) == g) { mlo = (unsigned)lo; mhi = (unsigned)hi; }
        }
#undef D1_KIDX
        { const int chunk = 4 * (lane & 15) + (lane >> 4);
          if ((lane & 15) < 8 && chunk < nchunk) MASK[(size_t)(rowbase + q) * 32 + chunk] = ((unsigned long long)mhi << 32) | mlo; }
    }
    __syncthreads();
}
}

namespace rw {
__device__ __forceinline__ void ln_store(f32x4 (&v)[4], const float* g, const float* bb, float* of, bf16* ob, int lane) {
    float s = 0.f;
#pragma unroll
    for (int j = 0; j < 4; ++j) s += (v[j][0] + v[j][1]) + (v[j][2] + v[j][3]);
    const float mean = wave_sum(s) * (1.0f / DM); float s2 = 0.f;
#pragma unroll
    for (int j = 0; j < 4; ++j) { v[j] = v[j] - mean; s2 += (v[j][0] * v[j][0] + v[j][1] * v[j][1]) + (v[j][2] * v[j][2] + v[j][3] * v[j][3]); }
    const float rstd = rsqrtf(wave_sum(s2) * (1.0f / DM) + LN_EPS);
#pragma unroll
    for (int j = 0; j < 4; ++j) {
        const f32x4 gg = *(const f32x4*)(g + 4 * lane + 256 * j), b4 = *(const f32x4*)(bb + 4 * lane + 256 * j);
        const f32x4 o = v[j] * rstd * gg + b4;
        *(f32x4*)(of + 4 * lane + 256 * j) = o;
        u32x2 w; w.x = pk2(o[0], o[1]); w.y = pk2(o[2], o[3]);
        *(u32x2*)(ob + 4 * lane + 256 * j) = w;
    }
}
template <int R, bool MAP8 = false, bool F8OUT = false>
__device__ __forceinline__ void ln_store_n(f32x4 (&v)[R][4], const float* g, const float* bb, float* const (&of)[R], bf16* const (&ob)[R], int lane, long lo_off = 0, unsigned char* f8 = nullptr, const bf16* ob0 = nullptr) {
    float s[R], s2[R]; int f8lo[R];
#pragma unroll
    for (int r = 0; r < R; ++r) { s[r] = 0.f;
#pragma unroll
        for (int j = 0; j < 4; ++j) s[r] += (v[r][j][0] + v[r][j][1]) + (v[r][j][2] + v[r][j][3]); }
#pragma unroll
    for (int o = 1; o < 64; o <<= 1)
#pragma unroll
        for (int r = 0; r < R; ++r) s[r] += __shfl_xor(s[r], o);
#pragma unroll
    for (int r = 0; r < R; ++r) { const float mean = s[r] * (1.0f / DM); s2[r] = 0.f;
#pragma unroll
        for (int j = 0; j < 4; ++j) { v[r][j] = v[r][j] - mean; s2[r] += (v[r][j][0] * v[r][j][0] + v[r][j][1] * v[r][j][1]) + (v[r][j][2] * v[r][j][2] + v[r][j][3] * v[r][j][3]); } }
#pragma unroll
    for (int o = 1; o < 64; o <<= 1)
#pragma unroll
        for (int r = 0; r < R; ++r) s2[r] += __shfl_xor(s2[r], o);
#pragma unroll
    for (int j = 0; j < 4; ++j) {
        const int col = MAP8 ? (512 * (j >> 1) + 8 * lane + 4 * (j & 1)) : (4 * lane + 256 * j);
        const f32x4 gg = *(const f32x4*)(g + col), b4 = *(const f32x4*)(bb + col);
#pragma unroll
        for (int r = 0; r < R; ++r) {
            const float rstd = rsqrtf(s2[r] * (1.0f / DM) + LN_EPS);
            const f32x4 o = v[r][j] * rstd * gg + b4;
            if (of[r]) *(f32x4*)(of[r] + col) = o;
            u32x2 w; w.x = pk2(o[0], o[1]); w.y = pk2(o[2], o[3]);
            *(u32x2*)(ob[r] + col) = w;
            if (lo_off) { u32x2 wl; wl.x = pk2(o[0] - bflo(w.x), o[1] - bfhi(w.x)); wl.y = pk2(o[2] - bflo(w.y), o[3] - bfhi(w.y)); *(u32x2*)(ob[r] + lo_off + col) = wl; }
            if constexpr (F8OUT && MAP8) {
                int t = 0; t = __builtin_amdgcn_cvt_pk_fp8_f32(o[0], o[1], t, false); t = __builtin_amdgcn_cvt_pk_fp8_f32(o[2], o[3], t, true);
                if ((j & 1) == 0) f8lo[r] = t; else *(u32x2*)(f8 + (ob[r] - ob0) + 512 * (j >> 1) + 8 * lane) = (u32x2){(unsigned)f8lo[r], (unsigned)t}; } }
    }
}
__device__ __forceinline__ void route_row(const float* sc, const float* bias, int lane, int (&e)[8], float (&w)[8]) {
    const f32x4 s4 = *(const f32x4*)(sc + 4 * lane), b4 = *(const f32x4*)(bias + 4 * lane);
    float bv[4] = {s4[0] + b4[0], s4[1] + b4[1], s4[2] + b4[2], s4[3] + b4[3]};
    float a = fmaxf(bv[0], bv[1]), b = fminf(bv[0], bv[1]), c = fmaxf(bv[2], bv[3]), d = fminf(bv[2], bv[3]);
    float m1 = fmaxf(a, c), m2 = fmaxf(fminf(a, c), fmaxf(b, d));
#pragma unroll
    for (int off = 1; off < 8; off <<= 1) { const float o1 = __shfl_xor(m1, off), o2 = __shfl_xor(m2, off); const float n1 = fmaxf(m1, o1), n2 = fmaxf(fminf(m1, o1), fmaxf(m2, o2)); m1 = n1; m2 = n2; }
    const float gs = m1 + m2; const int grp = lane >> 3;
    int rank = 0;
#pragma unroll
    for (int jg = 0; jg < 8; ++jg) { const float o = __shfl(gs, jg * 8); rank += (o > gs || (o == gs && jg < grp)) ? 1 : 0; }
    const bool sel = rank < 4;
    float mv[4];
#pragma unroll
    for (int i = 0; i < 4; ++i) mv[i] = sel ? bv[i] : -INFINITY;
    float wsum = 0.f;
#pragma unroll
    for (int r = 0; r < 8; ++r) {
        float best = mv[0]; int bi = 0;
#pragma unroll
        for (int i = 1; i < 4; ++i) if (mv[i] > best) { best = mv[i]; bi = i; }
        int idx = 4 * lane + bi;
#pragma unroll
        for (int off = 32; off >= 1; off >>= 1) { const float ov = __shfl_xor(best, off); const int oi = __shfl_xor(idx, off); if (ov > best || (ov == best && oi < idx)) { best = ov; idx = oi; } }
        const int ow = idx >> 2, oi4 = idx & 3;
        const float sv = oi4 == 0 ? s4[0] : oi4 == 1 ? s4[1] : oi4 == 2 ? s4[2] : s4[3];
        w[r] = __shfl(sv, ow); e[r] = idx; wsum += w[r];
        if (lane == ow) {
#pragma unroll
            for (int i = 0; i < 4; ++i) if (i == oi4) mv[i] = -INFINITY; }
    }
    const float sc8 = 2.5f / wsum;
#pragma unroll
    for (int r = 0; r < 8; ++r) w[r] *= sc8;
}
template <int CTRL> __device__ __forceinline__ float dppf(float v) { return __builtin_bit_cast(float, __builtin_amdgcn_update_dpp(0, __builtin_bit_cast(int, v), CTRL, 0xf, 0xf, false)); }
__device__ __forceinline__ float wave_max(float v) {
    v = fmaxf(v, dppf<0xB1>(v)); v = fmaxf(v, dppf<0x4E>(v)); v = fmaxf(v, dppf<0x141>(v)); v = fmaxf(v, dppf<0x140>(v));
    const float a = __builtin_bit_cast(float, __builtin_amdgcn_readlane(__builtin_bit_cast(int, v), 0)), b = __builtin_bit_cast(float, __builtin_amdgcn_readlane(__builtin_bit_cast(int, v), 16));
    const float c = __builtin_bit_cast(float, __builtin_amdgcn_readlane(__builtin_bit_cast(int, v), 32)), d = __builtin_bit_cast(float, __builtin_amdgcn_readlane(__builtin_bit_cast(int, v), 48));
    return fmaxf(fmaxf(a, b), fmaxf(c, d));
}
template <int R>
__device__ __forceinline__ void route_rows(const float* sc, const float* bias, int lane, int (&e)[R][8], float (&w)[R][8]) {
    const f32x4 b4 = *(const f32x4*)(bias + 4 * lane);
    f32x4 s4[R]; float bv[R][4], m1[R], m2[R], mv[R][4], wsum[R];
#pragma unroll
    for (int r = 0; r < R; ++r) { s4[r] = *(const f32x4*)(sc + (size_t)r * 256 + 4 * lane);
#pragma unroll
        for (int i = 0; i < 4; ++i) bv[r][i] = s4[r][i] + b4[i];
        const float a = fmaxf(bv[r][0], bv[r][1]), b = fminf(bv[r][0], bv[r][1]), c = fmaxf(bv[r][2], bv[r][3]), d = fminf(bv[r][2], bv[r][3]);
        m1[r] = fmaxf(a, c); m2[r] = fmaxf(fminf(a, c), fmaxf(b, d)); }
#pragma unroll
    for (int r = 0; r < R; ++r) {
        { const float o1 = dppf<0xB1>(m1[r]), o2 = dppf<0xB1>(m2[r]); const float n1 = fmaxf(m1[r], o1), n2 = fmaxf(fminf(m1[r], o1), fmaxf(m2[r], o2)); m1[r] = n1; m2[r] = n2; }
        { const float o1 = dppf<0x4E>(m1[r]), o2 = dppf<0x4E>(m2[r]); const float n1 = fmaxf(m1[r], o1), n2 = fmaxf(fminf(m1[r], o1), fmaxf(m2[r], o2)); m1[r] = n1; m2[r] = n2; }
        { const float o1 = dppf<0x141>(m1[r]), o2 = dppf<0x141>(m2[r]); const float n1 = fmaxf(m1[r], o1), n2 = fmaxf(fminf(m1[r], o1), fmaxf(m2[r], o2)); m1[r] = n1; m2[r] = n2; }
    }
    const int grp = lane >> 3;
#pragma unroll
    for (int r = 0; r < R; ++r) { const float gs = m1[r] + m2[r]; int rank = 0; wsum[r] = 0.f;
#pragma unroll
        for (int jg = 0; jg < 8; ++jg) { const float o = __builtin_bit_cast(float, __builtin_amdgcn_readlane(__builtin_bit_cast(int, gs), jg * 8)); rank += (o > gs || (o == gs && jg < grp)) ? 1 : 0; }
#pragma unroll
        for (int i = 0; i < 4; ++i) mv[r][i] = (rank < 4) ? bv[r][i] : -INFINITY; }
#pragma unroll
    for (int rd = 0; rd < 8; ++rd) {
#pragma unroll
        for (int r = 0; r < R; ++r) {
            const float M = wave_max(fmaxf(fmaxf(mv[r][0], mv[r][1]), fmaxf(mv[r][2], mv[r][3])));
            const int bi = (mv[r][0] == M) ? 0 : (mv[r][1] == M) ? 1 : (mv[r][2] == M) ? 2 : (mv[r][3] == M) ? 3 : 4;
            const unsigned long long bal = __ballot(bi < 4);
            const int ow = __builtin_amdgcn_readfirstlane((int)__ffsll((unsigned long long)bal) - 1);
            const float sv = bi == 0 ? s4[r][0] : bi == 1 ? s4[r][1] : bi == 2 ? s4[r][2] : s4[r][3];
            const int oi4 = __builtin_amdgcn_readlane(bi, ow);
            w[r][rd] = __builtin_bit_cast(float, __builtin_amdgcn_readlane(__builtin_bit_cast(int, sv), ow)); e[r][rd] = 4 * ow + oi4; wsum[r] += w[r][rd];
            if (lane == ow) {
#pragma unroll
                for (int i = 0; i < 4; ++i) if (i == oi4) mv[r][i] = -INFINITY; }
        }
    }
#pragma unroll
    for (int r = 0; r < R; ++r) { const float sc8 = 2.5f / wsum[r];
#pragma unroll
        for (int k = 0; k < 8; ++k) w[r][k] *= sc8; }
}
__device__ __forceinline__ void expert_tables(const unsigned* cnt  , LAS int* tp, LAS int* st) {
    __syncthreads();
    int tid_ = threadIdx.x; asm volatile("" : "+v"(tid_));
    if (tid_ < 64) {
        const int lane = tid_;
        int c[4], tl[4]; int cs = 0, ts = 0;
#pragma unroll
        for (int i = 0; i < 4; ++i) { c[i] = (int)__hip_atomic_load(cnt + 64 * (4 * lane + i), RLX_AGENT); tl[i] = (c[i] + 255) >> 8; cs += c[i]; ts += tl[i]; }
        int ci = cs, ti = ts;
#pragma unroll
        for (int off = 1; off < 64; off <<= 1) { const int n1 = __shfl_up(ci, off), n2 = __shfl_up(ti, off); if (lane >= off) { ci += n1; ti += n2; } }
        int ce = ci - cs, te = ti - ts;
#pragma unroll
        for (int i = 0; i < 4; ++i) { st[4 * lane + i] = ce; tp[4 * lane + i] = te; ce += c[i]; te += tl[i]; }
        if (lane == 63) { st[256] = ce; tp[256] = te; st[257] = ce + NTOK; tp[257] = te + NTOK / 256; }
    }
    __syncthreads();
}
}

namespace pro {
__device__ __forceinline__ int in_src_col(int p) {
    const int tile = p >> 8, c = p & 255;
    if (tile < 12) { const int br = tile / 3, kind = tile % 3;
        const int segbase = (br == 0 ? 0 : br == 1 ? 768 : br == 2 ? 1536 : 2308) + kind * 256;
        int orig = c;
        if (kind < 2) { if (br == 0 || br == 3) { const int pp = c & 63; orig = (c & ~63) + (pp >> 1) + 32 * (pp & 1); }
                        else if (br == 1) { const int pp = c & 31; orig = (c & ~31) + (pp >> 1) + 16 * (pp & 1); } }
        return segbase + orig; }
    if (tile == 12) { const int pp = c & 63; return 3076 + (c & ~63) + (pp >> 1) + 32 * (pp & 1); }
    if (tile == 13) { if (c < 64) return 3332 + (c >> 1) + 32 * (c & 1); if (c < 68) return 2304 + (c - 64); if (c < 72) return 3396 + (c - 68); return -1; }
    return 3400 + (tile - 14) * 256 + c;
}
template <class F>
__device__ __forceinline__ void transpose_item(const float* W, int ldw, int K, bf16* WT, int rs, int ro, LAS float* scr, int kb, int nb, int lane, F srcc) {
    const int k0 = 64 * kb, n0 = 32 * nb;
    const int sc = srcc(n0 + (lane & 31));
#pragma unroll 8
    for (int i = 0; i < 32; ++i) { const int kk = 2 * i + (lane >> 5); scr[kk * 33 + (lane & 31)] = (sc >= 0) ? W[(size_t)(k0 + kk) * ldw + sc] : 0.f; }
    LDS_WAIT(); asm volatile("" ::: "memory");
    const int c = lane & 7;
#pragma unroll
    for (int j = 0; j < 4; ++j) { const int n = (lane >> 3) + 8 * j; const LAS float* s = scr + (8 * c) * 33 + n;
        u32x4 o; o.x = pk2(s[0 * 33], s[1 * 33]); o.y = pk2(s[2 * 33], s[3 * 33]); o.z = pk2(s[4 * 33], s[5 * 33]); o.w = pk2(s[6 * 33], s[7 * 33]);
        *(u32x4*)(WT + (size_t)((n0 + n) * rs + ro) * K + k0 + 8 * c) = o; }
    LDS_WAIT(); asm volatile("" ::: "memory");
}
__device__ __forceinline__ unsigned pk2lo(float a, float b) { const unsigned h = pk2(a, b); return pk2(a - bflo(h), b - bfhi(h)); }
__device__ __forceinline__ void transpose_load_v4(f32x4 (&v)[8], const float* W, int ldw, int kb, int nb, int lane) {
    const float* src = W + (size_t)(64 * kb + (lane >> 3)) * ldw + 32 * nb + (lane & 7) * 4;
#pragma unroll
    for (int i = 0; i < 8; ++i) v[i] = *(const f32x4*)(src + (size_t)(8 * i) * ldw);
}
template <bool LO = false>
__device__ __forceinline__ void transpose_finish_v4(const f32x4 (&v)[8], int K, bf16* WT, int rs, int ro, LAS float* scr, int kb, int nb, int lane) {
    const int k0 = 64 * kb, n0 = 32 * nb;
#pragma unroll
    for (int i = 0; i < 8; ++i) *(LAS f32x4*)(scr + (8 * i + (lane >> 3)) * 36 + (lane & 7) * 4) = v[i];
    LDS_WAIT(); asm volatile("" ::: "memory");
    const int c = lane & 7;
#pragma unroll
    for (int j = 0; j < 4; ++j) { const int n = (lane >> 3) + 8 * j; const LAS float* s = scr + (8 * c) * 36 + n;
        u32x4 o;
        if (LO) { o.x = pk2lo(s[0 * 36], s[1 * 36]); o.y = pk2lo(s[2 * 36], s[3 * 36]); o.z = pk2lo(s[4 * 36], s[5 * 36]); o.w = pk2lo(s[6 * 36], s[7 * 36]); }
        else { o.x = pk2(s[0 * 36], s[1 * 36]); o.y = pk2(s[2 * 36], s[3 * 36]); o.z = pk2(s[4 * 36], s[5 * 36]); o.w = pk2(s[6 * 36], s[7 * 36]); }
        *(u32x4*)(WT + (size_t)((n0 + n) * rs + ro) * K + k0 + 8 * c) = o; }
    LDS_WAIT(); asm volatile("" ::: "memory");
}
__device__ __forceinline__ void transpose_finish_f8(const f32x4 (&v)[8], int K, unsigned char* WT, float scl, LAS float* scr, int kb, int nb, int lane, int rs = 1, int ro = 0) {
    const int k0 = 64 * kb, n0 = 32 * nb;
#pragma unroll
    for (int i = 0; i < 8; ++i) *(LAS f32x4*)(scr + (8 * i + (lane >> 3)) * 36 + (lane & 7) * 4) = v[i];
    LDS_WAIT(); asm volatile("" ::: "memory");
    const int c = lane & 3;
#pragma unroll
    for (int j = 0; j < 2; ++j) { const int n = (lane >> 2) + 16 * j; const LAS float* s = scr + (16 * c) * 36 + n;
        int w[4];
#pragma unroll
        for (int q = 0; q < 4; ++q) { int t = 0; t = __builtin_amdgcn_cvt_pk_fp8_f32(s[(4 * q + 0) * 36] * scl, s[(4 * q + 1) * 36] * scl, t, false);
            t = __builtin_amdgcn_cvt_pk_fp8_f32(s[(4 * q + 2) * 36] * scl, s[(4 * q + 3) * 36] * scl, t, true); w[q] = t; }
        *(u32x4*)(WT + ((size_t)(n0 + n) * rs + ro) * K + k0 + 16 * c) = (u32x4){(unsigned)w[0], (unsigned)w[1], (unsigned)w[2], (unsigned)w[3]}; }
    LDS_WAIT(); asm volatile("" ::: "memory");
}
template <bool LO = false>
__device__ __forceinline__ void transpose_item_v4(const float* W, int ldw, int K, bf16* WT, int rs, int ro, LAS float* scr, int kb, int nb, int lane) {
    f32x4 v[8]; transpose_load_v4(v, W, ldw, kb, nb, lane); transpose_finish_v4<LO>(v, K, WT, rs, ro, scr, kb, nb, lane);
}
struct IdCol { __device__ __forceinline__ int operator()(int n) const { return n; } };
struct InCol { __device__ __forceinline__ int operator()(int n) const { return in_src_col(n); } };
}

constexpr int NPHASE = 17;
#ifndef PHM
#define PHM 0x1ff
#endif
#define PH_EN(k) (((PHM) >> (k)) & 1)
#ifndef REP_P0
#define REP_P0 1
#endif
#ifndef REP_A
#define REP_A 1
#endif
#ifndef REP_B
#define REP_B 1
#endif
#ifndef REP_C
#define REP_C 1
#endif
#ifndef REP_D
#define REP_D 1
#endif
#ifndef REP_F
#define REP_F 1
#endif
#ifndef REP_E
#define REP_E 1
#endif
#ifndef REP_H
#define REP_H 1
#endif
#ifndef REP_G
#define REP_G 1
#endif
#define REPEAT(n) _Pragma("unroll 1") for (int rep = 0; rep < (n); ++rep)
#define REP_SYNC do { if (rep) xcd_barrier(bar); } while (0)
#ifndef ROUTER_HILO
#define ROUTER_HILO 0
#endif
#ifndef GNULL
#define GNULL 0
#endif
#ifndef BMASK
#define BMASK 7
#endif
#ifndef EMASK
#define EMASK 15
#endif
struct Args { const float* in[19]; float* out; unsigned char* ws; int ph_lo, ph_hi; };
__global__ void __launch_bounds__(NTHREADS, 2) mk_fwd(Args args) {
    extern __shared__ __attribute__((aligned(16))) unsigned char lds_raw[];
    LAS unsigned char* lds = (LAS unsigned char*)lds_raw;
    volatile LAS unsigned* MISC = (volatile LAS unsigned*)(lds + LX_MISC);
    LAS int* TP = (LAS int*)(lds + LX_TP); LAS int* ST = (LAS int*)(lds + LX_ST);
    unsigned char* ws = args.ws;
    unsigned* ctl = (unsigned*)(ws + WS_CTL);
    for (int u = threadIdx.x; u < (LDS_BYTES - LX_BASE) / 4; u += NTHREADS) ((LAS unsigned*)(lds + LX_BASE))[u] = 0u;
    __syncthreads();
    XcdBarrier bar; bar.bar = ctl + CW_BAR; bar.x = 0; bar.st = MISC + 8;
#if MK_ONE_LAUNCH
    bar = xcd_barrier_post(ctl + CW_BAR, MISC + 8);
#endif
    const int lo = args.ph_lo, hi = args.ph_hi;
#define IN(k) (lo <= (k) && (k) < hi)
#define SEAM(k) do { if (IN(k) && IN((k) + 1)) xcd_barrier(bar); } while (0)
#define QNEXT(ctr, dst) do { __syncthreads(); int t0_ = threadIdx.x; asm volatile("" : "+v"(t0_)); if (t0_ == 0) MISC[0] = __hip_atomic_fetch_add((ctr), 1u, RLX_AGENT); __syncthreads(); dst = (int)MISC[0]; } while (0)
#define KARGS const __attribute__((address_space(4))) Args* ka = (const __attribute__((address_space(4))) Args*)__builtin_amdgcn_kernarg_segment_ptr(); asm volatile("" : "+s"(ka))
#define QPREF(ctr) int qn_ = 0; { int t0_ = threadIdx.x; asm volatile("" : "+v"(t0_)); if (t0_ == 0) qn_ = (int)__hip_atomic_fetch_add((ctr), 1u, RLX_AGENT); }
#define QTAKE(dst) do { __syncthreads(); int t0_ = threadIdx.x; asm volatile("" : "+v"(t0_)); if (t0_ == 0) MISC[0] = (unsigned)qn_; __syncthreads(); dst = (int)MISC[0]; } while (0)
#define OPAQUE_CG int c = blockIdx.x, G = gridDim.x; asm volatile("" : "+s"(c), "+s"(G))
#define OPAQUE_IDS int tid = threadIdx.x; asm volatile("" : "+v"(tid)); const int lane = tid & 63, wid = __builtin_amdgcn_readfirstlane(tid >> 6); (void)lane; (void)wid
    bf16* const XB = (bf16*)(ws + A_X1B);

    if (PH_EN(8) && IN(0)) REPEAT(REP_P0) {
        REP_SYNC;
        OPAQUE_IDS; KARGS; OPAQUE_CG;
        LAS float* scr = (LAS float*)(lds + wid * 16384);
        const int gw = c * NWAVES + wid, NGW = G * NWAVES;
        constexpr int I_IN = 16 * 112, I_G8 = 16 * 128, I_BR = 4 * 128, I_WO = 512, I_WR = 128, I_L = I_IN + I_G8 + I_BR + I_WO + 2 * I_WR;
        for (int it = gw; it < 2 * I_L; it += NGW) {
            const int l = it / I_L; int r = it % I_L;
            unsigned char* dw = ws + WS_DENSE + (size_t)l * DENSE_L;
            if (r < I_IN) { pro::transpose_item(ka->in[1] + (size_t)l * 1024 * IN_SRC, IN_SRC, 1024, (bf16*)(dw + DW_WIN), 1, 0, scr, r / 112, r % 112, lane, pro::InCol()); continue; } r -= I_IN;
            if (r < I_G8) { f32x4 v8[8]; pro::transpose_load_v4(v8, ka->in[1] + (size_t)l * 1024 * IN_SRC + 3400, IN_SRC, r / 128, r % 128, lane);
                pro::transpose_finish_f8(v8, 1024, dw + DW_WG8, -32.0f * LOG2E, scr, r / 128, r % 128, lane); continue; } r -= I_G8;
            if (r < I_BR) { const int bi = r / 128, rr = r % 128;
                pro::transpose_item_v4(ka->in[5] + ((size_t)l * 4 + bi) * 256 * 1024, 1024, 256, (bf16*)(dw + DW_BR) + (size_t)bi * 1024 * 256, 1, 0, scr, rr / 32, rr % 32, lane); continue; } r -= I_BR;
            if (r < I_WO) { pro::transpose_item_v4(ka->in[6] + (size_t)l * 1024 * 1024, 1024, 1024, (bf16*)(dw + DW_WO), 1, 0, scr, r / 32, r % 32, lane); continue; } r -= I_WO;
            if (r < I_WR) pro::transpose_item_v4(ka->in[9] + (size_t)l * 1024 * 256, 256, 1024, (bf16*)(dw + DW_WR), 1, 0, scr, r / 8, r % 8, lane);
            else { r -= I_WR; pro::transpose_item_v4<true>(ka->in[9] + (size_t)l * 1024 * 256, 256, 1024, (bf16*)(dw + DW_WR) + 256 * 1024, 1, 0, scr, r / 8, r % 8, lane); }
        }
        for (int m = gw; m < NTOK; m += NGW) {
            const float* xr = ka->in[0] + (size_t)m * DM + 8 * lane;
#pragma unroll
            for (int j = 0; j < 2; ++j) { const f32x4 a = *(const f32x4*)(xr + 512 * j), b = *(const f32x4*)(xr + 512 * j + 4);
                u32x4 w; w.x = pk2(a[0], a[1]); w.y = pk2(a[2], a[3]); w.z = pk2(b[0], b[1]); w.w = pk2(b[2], b[3]);
                *(u32x4*)(XB + (size_t)m * DM + 512 * j + 8 * lane) = w;
                int f0 = 0, f1 = 0; f0 = __builtin_amdgcn_cvt_pk_fp8_f32(a[0], a[1], f0, false); f0 = __builtin_amdgcn_cvt_pk_fp8_f32(a[2], a[3], f0, true);
                f1 = __builtin_amdgcn_cvt_pk_fp8_f32(b[0], b[1], f1, false); f1 = __builtin_amdgcn_cvt_pk_fp8_f32(b[2], b[3], f1, true);
                *(u32x2*)(ws + A_XB8 + (size_t)m * DM + 512 * j + 8 * lane) = (u32x2){(unsigned)f0, (unsigned)f1}; }
        }
    }
    SEAM(0);

    for (int l = 0; l < 2; ++l) {
        const int pb = 1 + 8 * l;
        unsigned char* dw = ws + WS_DENSE + (size_t)l * DENSE_L;
        unsigned* cnt = ctl + CW_CNT + l * 16384;
        const float lam_init = (l == 0) ? 0.2f : 0.35550906759096926f;
        bf16* const TB = (bf16*)(ws + A_TB);
#define TBS(s) (TB + (size_t)(s) * (16u << 20))

        if (PH_EN(0) && IN(pb + 0)) REPEAT(REP_A) {
            REP_SYNC;
            KARGS; OPAQUE_CG;
            { gm::GridOrder<1024> S; S.init(XB, dw + DW_WIN, NTOK / 256, 14, G, c);
              ep::InProj E{ws, ka->in[2] + 4 * l};
              gm::gemm_phase<1024, false, true>(lds, S, E); }
            { gm::GridOrder8<1024> S; S.init(ws + A_XB8, dw + DW_WG8, NTOK / 256, 16, G, c);
              ep::InGate E{ws + A_GATES};
              gm::gemm_phase<1024, false, true, ep::InGate, gm::GridOrder8<1024>, true, 0x7A7A7A7A>(lds, S, E); }
        }
        SEAM(pb + 0);

        if (PH_EN(1) && IN(pb + 1)) REPEAT(REP_B) {
            REP_SYNC;
            OPAQUE_CG; (void)c; (void)G;
            unsigned* qc = ctl + CW_Q + 64 * (l * 2 + 0) + 16 * rep;
            int task; QNEXT(qc, task);
            while (task < 144 + 2048) {
                QPREF(qc);
                if (task < 16) pre::cumsum_task(task, (const float*)(ws + WS_LOGF), (float*)(ws + WS_C2));
                else if (task < 144) pre::kmean_task(task - 16, TBS(4), (bf16*)(ws + WS_KMEAN));
                else { const int idx = task - 144; pre::d1_unit(idx & 31, 63 - (idx >> 5), TBS(12), (const bf16*)(ws + A_IDXK), (const float*)(ws + WS_IDXW), (float*)(ws + A_S), (unsigned long long*)(ws + A_MASK), lds, (rep + 1 < REP_B) ? BMASK : 7); }
                QTAKE(task);
            }
        }
        SEAM(pb + 1);

        if (PH_EN(2) && IN(pb + 2)) REPEAT(REP_C) {
            REP_SYNC;
            KARGS; OPAQUE_CG; (void)c; (void)G;
            unsigned* qc = ctl + CW_Q + 64 * (l * 2 + 1) + 16 * rep;
            att::Aux ax{ws, ka->in[3] + 128 * l, ka->in[4] + 64 * l, lam_init};
            int tk; QNEXT(qc, tk);
            while (tk < 4096 + 2056) {
                QPREF(qc);
                int u = -1, chunk = -1;
                if (tk < 6144) { const int g3 = tk / 3, ps = tk - 3 * g3; if (ps == 2) chunk = g3; else u = 2 * g3 + ps; } else chunk = 2048 + (tk - 6144);
                if (u >= 0) {
                    const int qb = 7 - (u >> 9), rem = u & 511, type = rem >> 7, bh = rem & 127, b = bh >> 2, h = bh & 3;
                    if (type == 0) att::attn_unit<1>(b, h, qb, ax, lds);
                    else if (type == 1) att::attn_unit<3>(b, h, qb, ax, lds);
                    else if (type == 2) att::attn_unit<2>(b, h, qb, ax, lds);
                    else att::attn_unit<0>(b, h, qb, ax, lds);
                } else
                    {
                        OPAQUE_IDS;
                        LAS float* scr = (LAS float*)(lds + wid * 16384);
#define XITEM(it_, SRC, LDW, KK, DST, RS, RO, KB, NB) \
            const int e##it_ = (it_) / 384, r##it_ = (it_) % 384, mat##it_ = r##it_ >> 7, sub##it_ = r##it_ & 127; \
            bf16* we##it_ = (bf16*)(ws + A_WEXP + (size_t)e##it_ * WEXP_E); \
            const float* SRC = mat##it_ < 2 ? ((e##it_ < 256) ? ka->in[11 + mat##it_] + ((size_t)l * 256 + e##it_) * 1024 * 256 : ka->in[14 + mat##it_] + (size_t)l * 1024 * 256) \
                                            : ((e##it_ < 256) ? ka->in[13] + ((size_t)l * 256 + e##it_) * 256 * 1024 : ka->in[16] + (size_t)l * 256 * 1024); \
            const int LDW = mat##it_ < 2 ? 256 : 1024, KK = mat##it_ < 2 ? 1024 : 256, RS = mat##it_ < 2 ? 2 : 1, RO = mat##it_ < 2 ? mat##it_ : 0; \
            bf16* DST = mat##it_ < 2 ? we##it_ : we##it_ + 512 * 1024; \
            const int KB = mat##it_ < 2 ? (sub##it_ >> 3) : (sub##it_ >> 5), NB = mat##it_ < 2 ? (sub##it_ & 7) : (sub##it_ & 31)
                        for (int pr = 0; pr < 3; ++pr) {
                            const int ita = chunk * 48 + wid * 6 + 2 * pr, itb = ita + 1;
                            XITEM(ita, srca, ldwa, kka, dsta, rsa, roa, kba, nba);
                            XITEM(itb, srcb, ldwb, kkb, dstb, rsb, rob, kbb, nbb);
                            f32x4 va[8], vb[8];
                            pro::transpose_load_v4(va, srca, ldwa, kba, nba, lane);
                            pro::transpose_load_v4(vb, srcb, ldwb, kbb, nbb, lane);
                            pro::transpose_finish_f8(va, kka, (unsigned char*)dsta, 32.0f, scr, kba, nba, lane, rsa, roa);
                            pro::transpose_finish_f8(vb, kkb, (unsigned char*)dstb, 32.0f, scr, kbb, nbb, lane, rsb, rob);
                        }
#undef XITEM
                    }
                QTAKE(tk);
            }
        }
        SEAM(pb + 2);

        if (PH_EN(3) && IN(pb + 3)) REPEAT(REP_D) {
            REP_SYNC;
            OPAQUE_IDS; KARGS; OPAQUE_CG;
            gm::MergeOrder S{{(const char*)(ws + A_O), (const char*)(ws + A_O + 32 * MiB), (const char*)(ws + A_O + 64 * MiB), (const char*)(ws + A_O + 96 * MiB)}, (const char*)(dw + DW_BR), G, c};
            ep::Merge E{(const unsigned char*)(ws + A_GATES), (bf16*)(ws + A_MERGED)};
            gm::gemm_phase<256, false, true>(lds, S, E);
        }
        if (IN(pb + 3) && IN(pb + 4)) { VM_WAIT(); __syncthreads(); }

        if (PH_EN(4) && IN(pb + 4)) REPEAT((l == 0) ? REP_E : 1) {
            REP_SYNC;
            OPAQUE_IDS; KARGS; OPAQUE_CG; (void)G;
            const bool dummy = (l == 0) && (rep + 1 < REP_E);
            unsigned* cnt = dummy ? ctl + CW_CNT + 2 * 16384 : ctl + CW_CNT + l * 16384;
            unsigned char* const ixb = dummy ? ws + AR + 1600 * MiB : ws;
            const int EPART = dummy ? EMASK : 15;
            const int pm = c;
            bf16* PRE = (bf16*)(ws + A_PRE); bf16* X1B = (bf16*)(ws + A_X1B); float* SC = (float*)(ws + A_SC);
            if (EPART & 1) { gm::PanelOrder<1024> S{(const char*)(ws + A_MERGED), (const char*)(dw + DW_WO), pm, 4}; ep::OutPre E{(const bf16*)X1B, PRE}; gm::gemm_phase<1024, false, false>(lds, S, E); }
            VM_WAIT(); __syncthreads();
            { int ln = lane, wv = wid; asm volatile("" : "+v"(ln), "+s"(wv));
            if (EPART & 2) for (int r = 0; r < 32; r += 4) { const size_t row = (size_t)pm * 256 + wv * 32 + r;
                f32x4 v[4][4]; float* of[4]; bf16* ob[4];
#pragma unroll
                for (int rr = 0; rr < 4; ++rr) { of[rr] = nullptr; ob[rr] = X1B + (row + rr) * DM;
#pragma unroll
                    for (int h = 0; h < 2; ++h) { const u32x4 pv = *(const u32x4*)(PRE + (row + rr) * DM + 512 * h + 8 * ln);
                        v[rr][2 * h] = (f32x4){bflo(pv.x), bfhi(pv.x), bflo(pv.y), bfhi(pv.y)}; v[rr][2 * h + 1] = (f32x4){bflo(pv.z), bfhi(pv.z), bflo(pv.w), bfhi(pv.w)}; } }
                rw::ln_store_n<4, true, true>(v, ka->in[7] + DM * l, ka->in[8] + DM * l, of, ob, ln, ROUTER_HILO ? (long)((A_X1L - A_X1B) / 2) : 0L, ws + A_X1F8, X1B); } }
            VM_WAIT(); __syncthreads();
            if (EPART & 4) { gm::RouterOrder S{(const char*)X1B, (const char*)(ws + A_X1L), (const char*)(dw + DW_WR), (const char*)(dw + DW_WR) + 256 * 1024 * 2, pm, ROUTER_HILO ? 3 : 1};
                ep::Router E{SC, ROUTER_HILO ? 2 : 0}; gm::gemm_phase<1024, false, false>(lds, S, E); }
            VM_WAIT(); __syncthreads();
            { int ln = lane, wv = wid, td = tid; asm volatile("" : "+v"(ln), "+s"(wv), "+v"(td));
            LAS unsigned* lcnt = (LAS unsigned*)(lds + LX_LCNT); LAS unsigned* lbase = (LAS unsigned*)(lds + LX_LBASE);
            int* eidx = (int*)(ixb + WS_EIDX); float* wsel = (float*)(ixb + WS_WSEL); int* slot = (int*)(ixb + WS_SLOT); int* rowl = dummy ? (int*)(ws + AR + 1700 * MiB) : (int*)(ws + A_ROWL);
            if (td < 256) { lcnt[td] = 0u; ((int*)(ws + WS_IDENT))[pm * 256 + td] = pm * 256 + td; }
            __syncthreads();
            if (EPART & 8) for (int r = 0; r < 32; r += 4) { const size_t t0 = (size_t)pm * 256 + wv * 32 + r;
                int e8[4][8]; float w8[4][8];
                rw::route_rows<4>(SC + t0 * 256, ka->in[10] + 256 * l, ln, e8, w8);
                if (ln < 32) { int me = 0; float mw = 0.f;
#pragma unroll
                    for (int rr = 0; rr < 4; ++rr)
#pragma unroll
                        for (int k = 0; k < 8; ++k) if (ln == rr * 8 + k) { me = e8[rr][k]; mw = w8[rr][k]; }
                    const unsigned ls = __hip_atomic_fetch_add(lcnt + me, 1u, __ATOMIC_RELAXED, __HIP_MEMORY_SCOPE_WORKGROUP);
                    eidx[t0 * 8 + ln] = me; wsel[t0 * 8 + ln] = mw; slot[t0 * 8 + ln] = (int)ls; } }
            VM_WAIT(); __syncthreads();
            if (td < 256) { const unsigned cc = lcnt[td]; lbase[td] = cc ? __hip_atomic_fetch_add(cnt + 64 * td, cc, RLX_AGENT) : 0u; }
            __syncthreads();
            if (EPART & 8) for (int idx = td; idx < 2048; idx += NTHREADS) { const size_t t = (size_t)pm * 256 + (idx >> 3); const int k = idx & 7;
                const int e = eidx[t * 8 + k]; const int s = slot[t * 8 + k] + (int)lbase[e]; slot[t * 8 + k] = s; rowl[(size_t)e * 65536 + s] = (int)t; } }
        }
        SEAM(pb + 4);

        if (PH_EN(5) && IN(pb + 5)) REPEAT(REP_F) {
            REP_SYNC;
            OPAQUE_CG;
            rw::expert_tables(cnt, TP, ST);
            gm::ExpertOrder<1024, 2, true, 1> S{TP, ST, (const int*)(ws + A_ROWL), (const int*)(ws + WS_IDENT), (const char*)(ws + A_X1F8), (const char*)(ws + A_WEXP), G, c};
            ep::E1 E{(bf16*)(ws + A_H)};
            gm::gemm_phase<1024, true, true, ep::E1, gm::ExpertOrder<1024, 2, true, 1>, true, 0x7A7A7A7A>(lds, S, E);
        }
        SEAM(pb + 5);

        if (PH_EN(6) && IN(pb + 6)) REPEAT(REP_G) {
            REP_SYNC;
            OPAQUE_CG;
            rw::expert_tables(cnt, TP, ST);
            gm::ExpertOrder<256, 4, false, 1> S{TP, ST, nullptr, nullptr, (const char*)(ws + A_H), (const char*)(ws + A_WEXP), G, c};
            ep::E2 E{(bf16*)(ws + A_Y), 0, ws + WS_DUMP};
            gm::gemm_phase<256, false, true, ep::E2, gm::ExpertOrder<256, 4, false, 1>, true, 0x7A7A7A7A, 0x7B7B7B7B, 8>(lds, S, E);
        }
        SEAM(pb + 6);

        if (PH_EN(7) && IN(pb + 7)) REPEAT(REP_H) {
            REP_SYNC;
            OPAQUE_IDS; KARGS; OPAQUE_CG;
            float* const hout = (rep + 1 < REP_H) ? (float*)(ws + A_WEXP) : ka->out;
            bf16* const hxb = (rep + 1 < REP_H) ? (bf16*)(ws + A_WEXP + 256 * MiB) : XB;
            rw::expert_tables(cnt, TP, ST);
            const int* eidx = (const int*)(ws + WS_EIDX); const float* wsel = (const float*)(ws + WS_WSEL); const int* slot = (const int*)(ws + WS_SLOT);
            const bf16* Y = (const bf16*)(ws + A_Y);
            const float* g2 = ka->in[17] + DM * l; const float* b2 = ka->in[18] + DM * l;
            const unsigned char* Y8 = (const unsigned char*)Y;
#define Y8ADD(dst, yv, wgt) do { _Pragma("unroll") for (int wi_ = 0; wi_ < 4; ++wi_) { const f32x2 lo_ = __builtin_amdgcn_cvt_pk_f32_fp8((int)(yv)[wi_], false), hi_ = __builtin_amdgcn_cvt_pk_f32_fp8((int)(yv)[wi_], true); \
                dst[wi_] = dst[wi_] + (f32x4){lo_[0], lo_[1], hi_[0], hi_[1]} * (wgt); } } while (0)
            for (int t0 = 2 * (c * NWAVES + wid); t0 < NTOK; t0 += 2 * G * NWAVES) {
                int d_[2]; float w_[2];
#pragma unroll
                for (int rr = 0; rr < 2; ++rr) { d_[rr] = 0; w_[rr] = 0.f;
                    if (lane < 8) { const size_t ix = (size_t)(t0 + rr) * 8 + lane; const int e_ = eidx[ix]; d_[rr] = ST[e_] + slot[ix]; w_[rr] = wsel[ix] * (1.0f / Y_SCALE); } }
                f32x4 v[2][4];
#pragma unroll
                for (int rr = 0; rr < 2; ++rr) { const bf16* xp = (const bf16*)(ws + A_X1B) + (size_t)(t0 + rr) * DM + 16 * lane;
                    const u32x4 ys = *(const u32x4*)(Y8 + ((size_t)ST[256] + t0 + rr) * DM + 16 * lane);
                    const u32x4 xa = *(const u32x4*)xp, xb2 = *(const u32x4*)(xp + 8);
                    v[rr][0] = (f32x4){bflo(xa.x), bfhi(xa.x), bflo(xa.y), bfhi(xa.y)} * ALPHA; v[rr][1] = (f32x4){bflo(xa.z), bfhi(xa.z), bflo(xa.w), bfhi(xa.w)} * ALPHA;
                    v[rr][2] = (f32x4){bflo(xb2.x), bfhi(xb2.x), bflo(xb2.y), bfhi(xb2.y)} * ALPHA; v[rr][3] = (f32x4){bflo(xb2.z), bfhi(xb2.z), bflo(xb2.w), bfhi(xb2.w)} * ALPHA;
                    Y8ADD(v[rr], ys, 1.0f / Y_SCALE); }
#pragma unroll
                for (int k = 0; k < 8; ++k)
#pragma unroll
                    for (int rr = 0; rr < 2; ++rr) { const int dk = __shfl(d_[rr], k); const float wk = __shfl(w_[rr], k);
                        const u32x4 y = *(const u32x4*)(Y8 + (size_t)dk * DM + 16 * lane); Y8ADD(v[rr], y, wk); }
                float s[2], s2[2];
#pragma unroll
                for (int rr = 0; rr < 2; ++rr) { s[rr] = 0.f;
#pragma unroll
                    for (int q = 0; q < 4; ++q) s[rr] += (v[rr][q][0] + v[rr][q][1]) + (v[rr][q][2] + v[rr][q][3]); }
#pragma unroll
                for (int o = 1; o < 64; o <<= 1)
#pragma unroll
                    for (int rr = 0; rr < 2; ++rr) s[rr] += __shfl_xor(s[rr], o);
#pragma unroll
                for (int rr = 0; rr < 2; ++rr) { const float mean = s[rr] * (1.0f / DM); s2[rr] = 0.f;
#pragma unroll
                    for (int q = 0; q < 4; ++q) { v[rr][q] = v[rr][q] - mean; s2[rr] += (v[rr][q][0] * v[rr][q][0] + v[rr][q][1] * v[rr][q][1]) + (v[rr][q][2] * v[rr][q][2] + v[rr][q][3] * v[rr][q][3]); } }
#pragma unroll
                for (int o = 1; o < 64; o <<= 1)
#pragma unroll
                    for (int rr = 0; rr < 2; ++rr) s2[rr] += __shfl_xor(s2[rr], o);
#pragma unroll
                for (int rr = 0; rr < 2; ++rr) { const float rstd = rsqrtf(s2[rr] * (1.0f / DM) + LN_EPS);
                    float* op = hout + (size_t)(t0 + rr) * DM + 16 * lane; f32x4 ov[4];
#pragma unroll
                    for (int i = 0; i < 4; ++i) { ov[i] = v[rr][i] * rstd * *(const f32x4*)(g2 + 16 * lane + 4 * i) + *(const f32x4*)(b2 + 16 * lane + 4 * i); if (l == 1) *(f32x4*)(op + 4 * i) = ov[i]; }
                    if (l == 1) continue;
                    u32x4 wa, wb; wa.x = pk2(ov[0][0], ov[0][1]); wa.y = pk2(ov[0][2], ov[0][3]); wa.z = pk2(ov[1][0], ov[1][1]); wa.w = pk2(ov[1][2], ov[1][3]);
                    wb.x = pk2(ov[2][0], ov[2][1]); wb.y = pk2(ov[2][2], ov[2][3]); wb.z = pk2(ov[3][0], ov[3][1]); wb.w = pk2(ov[3][2], ov[3][3]);
                    bf16* xb = hxb + (size_t)(t0 + rr) * DM + 16 * lane; *(u32x4*)xb = wa; *(u32x4*)(xb + 8) = wb;
                    int f8[4];
#pragma unroll
                    for (int i = 0; i < 4; ++i) { int t = 0; t = __builtin_amdgcn_cvt_pk_fp8_f32(ov[i][0], ov[i][1], t, false); t = __builtin_amdgcn_cvt_pk_fp8_f32(ov[i][2], ov[i][3], t, true); f8[i] = t; }
                    *(u32x4*)(ws + A_XB8 + (size_t)(t0 + rr) * DM + 16 * lane) = (u32x4){(unsigned)f8[0], (unsigned)f8[1], (unsigned)f8[2], (unsigned)f8[3]}; }
            }
#undef Y8ADD
        }
        SEAM(pb + 7);
#undef TBS
    }
#undef IN
#undef SEAM
#undef QNEXT
}

extern "C" void kernel_launch(void* const* d_in, const int* in_sizes, int n_in, void* d_out, int out_size, void* d_ws, size_t ws_size, hipStream_t stream) {
    static int grid = 0;
    if (grid == 0) {
        if (n_in != 19 || out_size != NTOK * DM || ws_size < WS_END) { fprintf(stderr, "kernel_launch: unexpected shapes: n_in %d out %d ws %zu (need %zu)\n", n_in, out_size, ws_size, (size_t)WS_END); grid = -1; return; }
        int dev = 0, cus = 0;
        if (hipGetDevice(&dev) != hipSuccess || hipDeviceGetAttribute(&cus, hipDeviceAttributeMultiprocessorCount, dev) != hipSuccess) { grid = -1; return; }
        if (hipFuncSetAttribute((const void*)mk_fwd, hipFuncAttributeMaxDynamicSharedMemorySize, LDS_BYTES) != hipSuccess) { fprintf(stderr, "kernel_launch: hipFuncSetAttribute failed\n"); grid = -1; return; }
        int per_cu = 0;
        if (hipOccupancyMaxActiveBlocksPerMultiprocessor(&per_cu, (const void*)mk_fwd, NTHREADS, LDS_BYTES) != hipSuccess || per_cu < 1) fprintf(stderr, "kernel_launch: occupancy query says %d\n", per_cu);
        (void)hipGetLastError();
        if (cus != 256) { fprintf(stderr, "kernel_launch: built for 256 CUs, device has %d\n", cus); grid = -1; return; }
        grid = 256;
    }
    if (grid < 0) return;
    (void)hipMemsetAsync((char*)d_ws + WS_CTL, 0, CTL_BYTES, stream);
    Args a{};
    for (int i = 0; i < 19; ++i) a.in[i] = (const float*)d_in[i];
    a.out = (float*)d_out; a.ws = (unsigned char*)d_ws;
#if MK_ONE_LAUNCH
    a.ph_lo = 0; a.ph_hi = NPHASE;
    hipLaunchKernelGGL(mk_fwd, dim3(grid), dim3(NTHREADS), LDS_BYTES, stream, a);
#else
    for (int p = 0; p < NPHASE; ++p) { a.ph_lo = p; a.ph_hi = p + 1; hipLaunchKernelGGL(mk_fwd, dim3(grid), dim3(NTHREADS), LDS_BYTES, stream, a); }
#endif
}
```

```cpp
#include <hip/hip_runtime.h>
#include <cstdio>
#include <cstdint>

#ifndef MK_ONE_LAUNCH
#define MK_ONE_LAUNCH 1
#endif

#define GAS __attribute__((address_space(1)))
#define LAS __attribute__((address_space(3)))
typedef unsigned short bf16;
typedef short bf16x8 __attribute__((ext_vector_type(8)));
typedef short s16x4 __attribute__((ext_vector_type(4)));
typedef float f32x2 __attribute__((ext_vector_type(2)));
typedef float f32x4 __attribute__((ext_vector_type(4)));
typedef float f32x16 __attribute__((ext_vector_type(16)));
typedef unsigned u32x2 __attribute__((ext_vector_type(2)));
typedef unsigned u32x4 __attribute__((ext_vector_type(4)));
typedef __bf16 bf16x2_t __attribute__((ext_vector_type(2)));
typedef GAS unsigned gu32;

constexpr int NTOK = 65536, DM = 1024, SEQ = 2048, NBATCH = 32, NEXP = 256, EFF = 256;
constexpr int NWAVES = 8, NTHREADS = 512;
constexpr float LN_EPS = 1e-5f;
constexpr float ALPHA = 1.41421356237309515f;
constexpr float LOG2E = 1.4426950408889634f;
constexpr float H_SCALE = 16.0f;
constexpr float Y_SCALE = 32.0f;
constexpr int IN_NTILES = 30, IN_NCOLS = IN_NTILES * 256, IN_SRC = 7496;

constexpr size_t MiB = 1u << 20;
constexpr size_t WS_CTL = 0, CTL_BYTES = 1 * MiB;
constexpr size_t WS_CS64 = 1 * MiB;
constexpr size_t WS_CS32 = WS_CS64 + 512 * 1024;
constexpr size_t WS_KMEAN = WS_CS32 + 256 * 1024;
constexpr size_t WS_C2 = 2 * MiB;
constexpr size_t WS_LOGF = 3 * MiB;
constexpr size_t WS_IDXW = 4 * MiB;
constexpr size_t WS_EIDX = 5 * MiB;
constexpr size_t WS_WSEL = 7 * MiB;
constexpr size_t WS_SLOT = 9 * MiB;
constexpr size_t WS_DUMP = 12 * MiB;
constexpr size_t WS_IDENT = 11 * MiB;
constexpr size_t WS_DENSE = 16 * MiB, DENSE_L = 20 * MiB;
constexpr size_t DW_WG8 = 7 * MiB;
constexpr size_t DW_WIN = 0, DW_BR = 15 * MiB, DW_WO = 17 * MiB, DW_WR = 19 * MiB;
constexpr size_t AR = 56 * MiB;
constexpr size_t A_XB = AR + 0 * MiB;
constexpr size_t A_XB8 = AR + 128 * MiB;
constexpr size_t A_GATES = AR + 1480 * MiB;
constexpr size_t A_MERGED = AR + 784 * MiB;
constexpr size_t A_S = AR + 272 * MiB;
constexpr size_t A_MASK = AR + 1040 * MiB;
constexpr size_t A_TB = AR + 1056 * MiB;
constexpr size_t A_IDXK = A_TB + 416 * MiB;
constexpr size_t A_O = AR + 912 * MiB;
constexpr size_t A_PRE = AR + 386 * MiB;
constexpr size_t A_X1B = AR + 1736 * MiB;
constexpr size_t A_X1F8 = AR + 1864 * MiB;
constexpr size_t A_X1L = AR + 1552 * MiB;
constexpr size_t A_ROWL = AR + 1296 * MiB;
constexpr size_t A_SC = AR + 1360 * MiB;
constexpr size_t A_WEXP = AR + 0 * MiB;
constexpr size_t A_H = AR + 386 * MiB;
constexpr size_t A_Y = AR + 674 * MiB;
constexpr size_t WS_END = 2048 * MiB;
constexpr size_t WEXP_E = 1536 * 1024;
static_assert(A_WEXP + 257 * WEXP_E <= A_H && A_H + (size_t)(589824 + 256) * 512 <= A_Y + 1 * MiB && A_Y + (size_t)589824 * 2048 <= WS_END && A_GATES + 512 * MiB <= WS_END && A_IDXK + 8 * MiB <= A_GATES
              && A_S + 512 * MiB <= A_MERGED && A_S >= A_XB + 128 * MiB && A_WEXP + 257 * WEXP_E <= A_MERGED && A_SC + 64 * MiB <= A_GATES && A_PRE + 128 * MiB <= A_Y && A_GATES + 256 * MiB <= A_X1B && A_X1B + 128 * MiB <= A_X1F8 && A_X1F8 + 64 * MiB <= WS_END, "ws map");

constexpr int CW_TMO = 0, CW_BAR = 4096, CW_Q = 8192  , CW_CNT = 16384  ;

constexpr int RING_BYTES = 131072;
constexpr int LX_BASE = 155648;
constexpr int LX_MISC = LX_BASE;
constexpr int LX_TP = LX_BASE + 256;
constexpr int LX_ST = LX_TP + 1056;
constexpr int LX_LCNT = LX_ST + 1056;
constexpr int LX_LBASE = LX_LCNT + 1024;
constexpr int LDS_BYTES = 163840;
static_assert(LX_LBASE + 1024 <= LDS_BYTES, "lds map");

#define RLX_AGENT __ATOMIC_RELAXED, __HIP_MEMORY_SCOPE_AGENT
#define LDS_WAIT() asm volatile("s_waitcnt lgkmcnt(0)" ::: "memory")
#define VM_WAIT() asm volatile("s_waitcnt vmcnt(0)" ::: "memory")
__device__ __forceinline__ unsigned pk2(float lo, float hi) { f32x2 v = {lo, hi}; bf16x2_t b = __builtin_convertvector(v, bf16x2_t); return __builtin_bit_cast(unsigned, b); }
__device__ __forceinline__ float bflo(unsigned w) { return __uint_as_float(w << 16); }
__device__ __forceinline__ float bfhi(unsigned w) { return __uint_as_float(w & 0xffff0000u); }
__device__ __forceinline__ float wave_sum(float v) {
#pragma unroll
    for (int o = 1; o < 64; o <<= 1) v += __shfl_xor(v, o);
    return v;
}
__device__ __forceinline__ float sigmoidf_(float z) { return __builtin_amdgcn_rcpf(1.0f + __builtin_amdgcn_exp2f(-1.4426950408889634f * z)); }

#define XB_TMO      128
#define XB_XCNT(j)  (256  + 64 * (j))
#define XB_XSUB(j)  (1280 + 64 * (j))
#define XB_XGEN(j)  (2304 + 64 * (j))
#define XB_TOP      3328
#define XB_TOPGEN   3392
#define XCD_BAR_WORDS 3456
#define XB_SPIN_CAP (1u << 22)
__device__ __forceinline__ unsigned xb_ld(unsigned* p)              { return __hip_atomic_load(p, __ATOMIC_RELAXED, __HIP_MEMORY_SCOPE_AGENT); }
__device__ __forceinline__ unsigned xb_add(unsigned* p, unsigned v) { return __hip_atomic_fetch_add(p, v, __ATOMIC_RELAXED, __HIP_MEMORY_SCOPE_AGENT); }
__device__ __forceinline__ unsigned xb_xcc_id() { return (unsigned)__builtin_amdgcn_s_getreg((3 << 11) | 20) & 0xFu; }
#define XB_SPIN(cond, bar) do { unsigned _sp = 0; while (cond) { __builtin_amdgcn_s_sleep(1); \
    if ((++_sp & 255u) == 0u) { if (xb_ld(&(bar)[XB_TMO])) break; if (_sp > XB_SPIN_CAP) { atomicAdd(&(bar)[XB_TMO], 1u); break; } } } } while (0)
struct XcdBarrier { unsigned* bar; unsigned x; volatile LAS unsigned* st; };
__device__ __forceinline__ XcdBarrier xcd_barrier_post(unsigned* bar, volatile LAS unsigned* st) {
    XcdBarrier b; b.bar = bar; b.x = xb_xcc_id(); b.st = st;
    if (threadIdx.x == 0) (void)xb_add(&bar[XB_XCNT(b.x)], 1u);
    return b;
}
__device__ __forceinline__ void xcd_barrier_complete(unsigned* bar, unsigned x, unsigned& nloc, unsigned& nx) {
    const unsigned G = gridDim.x * gridDim.y * gridDim.z;
    unsigned sum, cnt, mine, sp = 0u;
    for (;;) {
        sum = 0u; cnt = 0u; mine = 0u;
#pragma unroll
        for (unsigned j = 0; j < 16; ++j) { const unsigned c = xb_ld(&bar[XB_XCNT(j)]); sum += c; cnt += (c > 0u) ? 1u : 0u; mine = (j == x) ? c : mine; }
        if (sum == G) break;
        __builtin_amdgcn_s_sleep(1);
        if ((++sp & 255u) == 0u) { if (xb_ld(&bar[XB_TMO])) break; if (sp > XB_SPIN_CAP) { atomicAdd(&bar[XB_TMO], 1u); break; } }
    }
    nloc = mine > 0u ? mine : 1u; nx = cnt > 0u ? cnt : 1u;
}
__device__ __forceinline__ void xcd_barrier(const XcdBarrier& b) {
    asm volatile("s_waitcnt vmcnt(0)" ::: "memory");
    __syncthreads();
    int t0_ = threadIdx.x; asm volatile("" : "+v"(t0_));
    if (t0_ == 0) {
        unsigned* bar = b.bar;
        __builtin_amdgcn_s_waitcnt(0);
        unsigned nloc = b.st[0], nx = b.st[1];
        if (nloc == 0u) { xcd_barrier_complete(bar, b.x, nloc, nx); b.st[0] = nloc; b.st[1] = nx; }
        const unsigned old = xb_add(&bar[XB_XSUB(b.x)], 1u);
        const unsigned gen = old / nloc;
        if (old + 1u == (gen + 1u) * nloc) {
            __builtin_amdgcn_fence(__ATOMIC_RELEASE, "agent");
            asm volatile("s_waitcnt vmcnt(0)" ::: "memory");
            const unsigned og = xb_add(&bar[XB_TOP], 1u);
            const unsigned tg = og / nx;
            if (og + 1u == (tg + 1u) * nx) xb_add(&bar[XB_TOPGEN], 1u);
            else XB_SPIN(xb_ld(&bar[XB_TOPGEN]) == tg, bar);
            __builtin_amdgcn_fence(__ATOMIC_ACQUIRE, "agent");
            xb_add(&bar[XB_XGEN(b.x)], 1u);
            asm volatile("s_waitcnt vmcnt(0)" ::: "memory");
        } else {
            XB_SPIN(xb_ld(&bar[XB_XGEN(b.x)]) == gen, bar);
            __builtin_amdgcn_fence(__ATOMIC_ACQUIRE, "agent");
            asm volatile("s_waitcnt vmcnt(0)" ::: "memory");
        }
    }
    __syncthreads();
}

namespace gm {
constexpr int BM = 256, BK = 64, HALF = 128, HTB = HALF * BK * 2, STAGE_BYTES = 8 * HTB;
__device__ __forceinline__ int lds_byte(int r, int c) { const int st = (r >> 4) * 2 + (c >> 5), rr = r & 15, cc = c & 31, ob = rr * 64 + cc * 2; return st * 1024 + (ob ^ (((ob >> 9) & 1) << 5)); }
__device__ __forceinline__ void stage_rc(int b, int& R, int& C) { const int st = b / 1024, sb = b % 1024, swz = sb ^ (((sb >> 9) & 1) << 5); R = (st >> 1) * 16 + swz / 64; C = (st & 1) * 32 + (swz % 64) / 2; }
__device__ __forceinline__ int perm32(int rho) { const int n = rho >> 4, i = rho & 15; return 8 * (i >> 2) + 4 * n + (i & 3); }

struct GUnit { const char* A; const char* B; int pm, pn, e, nrows, row0, seg; };

typedef int i32x8 __attribute__((ext_vector_type(8)));
typedef int i32x8a __attribute__((ext_vector_type(8), aligned(16)));
typedef int i32x4_ __attribute__((ext_vector_type(4)));
__device__ __forceinline__ i32x8 ld32(const LAS unsigned char* p) { const i32x4_ a = *(const LAS i32x4_*)p, b = *(const LAS i32x4_*)(p + 16); return __builtin_shufflevector(a, b, 0, 1, 2, 3, 4, 5, 6, 7); }
template <int K, bool GATHER, bool ALIGN_EPI, class Epi, class Sched, bool F8 = false, int SCALE_E8M0 = 0x7F7F7F7F, int SCALE_A = 0x7F7F7F7F, int RELAX = 0>
__device__ __forceinline__ void gemm_phase(LAS unsigned char* lds, const Sched& S, const Epi& E) {
    constexpr int ESZ = F8 ? 1 : 2;
    int tid_ = threadIdx.x; asm volatile("" : "+v"(tid_));
    const int tid = tid_, wid = __builtin_amdgcn_readfirstlane(tid >> 6), lane = tid & 63, wr = wid >> 2, wc = wid & 3, fr = lane & 15, fq = lane >> 4;
    constexpr int nt = K * ESZ / (BK * 2);
    static_assert(K % 128 == 0 && K >= 256 && nt % 2 == 0 && nt >= (F8 ? 2 : 4), "K");
    static_assert(RELAX == 0 || (RELAX == 8 && nt == 2 && F8 && !GATHER), "RELAX");
    const int swz_ = (lane * 16) ^ ((((lane * 16) >> 9) & 1) << 5), r4 = swz_ >> 6, cb_ = swz_ & 63;
    const int Rhi0 = (wid >> 1) * 16, cu_ = (wid & 1) * 64;
    auto rbf = [](int R) { return Epi::ADJ == 2 ? (64 * (R >> 5) + 16 * ((R & 15) >> 2) + 4 * ((R >> 4) & 1) + (R & 3))
                                : Epi::ADJ == 1 ? (64 * (R >> 5) + perm32(R & 31)) : (Epi::PERM ? ((R & ~31) + perm32(R & 31)) : R); };
    const unsigned laneB = (unsigned)(rbf(r4) * K * ESZ + cb_), laneA = (unsigned)(r4 * K * ESZ + cb_);
    unsigned uB[2], uA[2][2];
#pragma unroll
    for (int i = 0; i < 2; ++i) { uB[i] = (unsigned)__builtin_amdgcn_readfirstlane(rbf(Rhi0 + 64 * i) * K * ESZ + cu_);
#pragma unroll
        for (int h = 0; h < 2; ++h) uA[h][i] = (unsigned)__builtin_amdgcn_readfirstlane((h * HALF + Rhi0 + 64 * i) * K * ESZ + cu_); }
    constexpr size_t bhstep = Epi::ADJ == 2 ? (size_t)8 * K * ESZ : Epi::ADJ == 1 ? (size_t)32 * K * ESZ : (size_t)HALF * K * ESZ;
    constexpr size_t kstep = (size_t)(BK * 2);
    constexpr size_t hstep = (size_t)HALF * K * ESZ;
    const unsigned ldsw = (unsigned)wid * 1024u;
    const int aoff = F8 ? (wr * 8192 + (fq >> 1) * 1024 + fr * 64 + (((fq & 1) ^ (fr >> 3)) << 5)) : lds_byte(wr * 64 + fr, fq * 8);
    const int boff = F8 ? (wc * 4096 + (fq >> 1) * 1024 + fr * 64 + (((fq & 1) ^ (fr >> 3)) << 5)) : lds_byte(wc * 32 + fr, fq * 8);
#define PG8_SA(b, h) (((b) * 2 + (h)) * HTB)
#define PG8_SB(b, h) ((4 + (b) * 2 + (h)) * HTB)
#define PG8_GLDS(gptr, bufoff, _i) __builtin_amdgcn_global_load_lds((const unsigned*)(gptr), (LAS unsigned*)(lds + (bufoff) + ldsw + (_i) * 8192), 16, 0, 0)
#define PG8_STAGE_B(bufoff, gbase) do { _Pragma("unroll") for (int _i = 0; _i < 2; ++_i) PG8_GLDS((const char*)(gbase) + uB[_i] + laneB, bufoff, _i); } while (0)
#define PG8_STAGE_A(bufoff, gbase, h, NX) do { _Pragma("unroll") for (int _i = 0; _i < 2; ++_i) { \
        if constexpr (GATHER) PG8_GLDS((const char*)(gbase) + ((NX) ? nvo[h][_i] : cvo[h][_i]), bufoff, _i); else PG8_GLDS((const char*)(gbase) + uA[h][_i] + laneA, bufoff, _i); } } while (0)
#define PG8_LDA(dst, b, h) do { if constexpr (F8) { _Pragma("unroll") for (int m = 0; m < 4; ++m) dst##8[m] = ld32(lds + PG8_SA(b, h) + aoff + m * 2048); } \
        else { _Pragma("unroll") for (int m = 0; m < 4; ++m) _Pragma("unroll") for (int k = 0; k < 2; ++k) dst[m][k] = *(const LAS bf16x8*)(lds + PG8_SA(b, h) + aoff + m * 2048 + k * 1024); } } while (0)
#define PG8_LDB(dst, b, h) do { if constexpr (F8) { _Pragma("unroll") for (int n = 0; n < 2; ++n) dst##8[n] = ld32(lds + PG8_SB(b, h) + boff + n * 2048); } \
        else { _Pragma("unroll") for (int n = 0; n < 2; ++n) _Pragma("unroll") for (int k = 0; k < 2; ++k) dst[n][k] = *(const LAS bf16x8*)(lds + PG8_SB(b, h) + boff + n * 2048 + k * 1024); } } while (0)
#define PG8_MMA(ai, bj, At, Bt) do { __builtin_amdgcn_s_setprio(1); \
        if constexpr (F8) { _Pragma("unroll") for (int m = 0; m < 4; ++m) _Pragma("unroll") for (int n = 0; n < 2; ++n) \
            asm volatile("s_nop 1\n\tv_mfma_scale_f32_16x16x128_f8f6f4 %0, %1, %2, %0, %3, %4 op_sel_hi:[0,0,0]" : "+v"(acc[ai][bj][m][n]) : "v"(Bt##8[n]), "v"(At##8[m]), "v"(sclB_), "v"(sclA_)); } \
        else { _Pragma("unroll") for (int m = 0; m < 4; ++m) _Pragma("unroll") for (int n = 0; n < 2; ++n) _Pragma("unroll") for (int k = 0; k < 2; ++k) \
            acc[ai][bj][m][n] = __builtin_amdgcn_mfma_f32_16x16x32_bf16(Bt[n][k], At[m][k], acc[ai][bj][m][n], 0, 0, 0); } \
        __builtin_amdgcn_s_setprio(0); } while (0)
#define PG8_WAIT_V(n) asm volatile("s_waitcnt vmcnt(" #n ")" ::: "memory")
#define PG8_WAIT_L(n) asm volatile("s_waitcnt lgkmcnt(" #n ")" ::: "memory")
#define PG8_WAIT_RLX do { if constexpr (RELAX == 8) { if (ui == 0) PG8_WAIT_V(8); else PG8_WAIT_V(16); } else PG8_WAIT_V(8); } while (0)
#define PG8_BAR __builtin_amdgcn_s_barrier()
#define PG8_SCHED __builtin_amdgcn_sched_barrier(0)
  \
#define PG8_SETVO(vo, u) do { int _t[2][2]; unsigned _c2[2]; _Pragma("unroll") for (int _i = 0; _i < 2; ++_i) { int _R, _C; stage_rc(tid * 16 + _i * 8192, _R, _C); _c2[_i] = (unsigned)_C * 2u; \
            _Pragma("unroll") for (int _h = 0; _h < 2; ++_h) _t[_h][_i] = S.rowtok(u, _h * HALF + _R); } \
        asm volatile("" : "+v"(_t[0][0]), "+v"(_t[0][1]), "+v"(_t[1][0]), "+v"(_t[1][1])); \
        _Pragma("unroll") for (int _i = 0; _i < 2; ++_i) _Pragma("unroll") for (int _h = 0; _h < 2; ++_h) vo[_h][_i] = (unsigned)_t[_h][_i] * (unsigned)(K * ESZ) + _c2[_i]; } while (0)
    int sclB_ = SCALE_E8M0, sclA_ = SCALE_A; asm volatile("" : "+v"(sclB_), "+v"(sclA_));
    GUnit cur, nxt; int ui = 0;
    if (!S.next(0, cur)) return;
    f32x4 acc[2][2][4][2];
#pragma unroll
    for (int a = 0; a < 2; ++a)
#pragma unroll
        for (int b = 0; b < 2; ++b)
#pragma unroll
            for (int m = 0; m < 4; ++m)
#pragma unroll
                for (int n = 0; n < 2; ++n) acc[a][b][m][n] = (f32x4){0.f, 0.f, 0.f, 0.f};
    bf16x8 At[4][2], B0[2][2], B1[2][2]; i32x8 At8[4], B08[2], B18[2];
    unsigned cvo[2][2], nvo[2][2];
    if constexpr (GATHER) { PG8_SETVO(cvo, cur); }
    const char* cA = cur.A; const char* cB = cur.B;
#define PG8_KOFF(rot_, tt_) ((size_t)(((tt_) + (rot_)) & (nt - 1)) * kstep)
    auto krot = [](const GUnit& u) { return (u.pm + u.pn + u.e) & (nt - 1); };
    int crot = krot(cur), nrot = 0;
    { const size_t k0_ = PG8_KOFF(crot, 0); PG8_STAGE_B(PG8_SB(0, 0), cB + k0_); PG8_STAGE_B(PG8_SB(0, 1), cB + bhstep + k0_); PG8_STAGE_A(PG8_SA(0, 0), cA + k0_, 0, false); PG8_STAGE_A(PG8_SA(0, 1), cA + k0_, 1, false); }
    if (wr == 1) PG8_BAR;
    PG8_WAIT_V(2); PG8_BAR;
    { const size_t k1_ = PG8_KOFF(crot, 1); PG8_STAGE_B(PG8_SB(1, 0), cB + k1_); PG8_STAGE_A(PG8_SA(1, 0), cA + k1_, 0, false); PG8_STAGE_B(PG8_SB(1, 1), cB + bhstep + k1_); }
    PG8_WAIT_V(6); PG8_BAR;
    for (;;) {
        const bool has_next = S.next(ui + 1, nxt);
        const char* nA = has_next ? nxt.A : cA; const char* nB = has_next ? nxt.B : cB; nrot = has_next ? krot(nxt) : crot;
        if constexpr (GATHER) {
            if (has_next) { PG8_SETVO(nvo, nxt); }
            else {
#pragma unroll
                for (int h = 0; h < 2; ++h)
#pragma unroll
                    for (int i = 0; i < 2; ++i) nvo[h][i] = cvo[h][i];
            }
        }
#pragma unroll 1
        for (int t = 0; t < nt; t += 2) {
            const bool last = (t == nt - 2);
            const char* a1 = cA + PG8_KOFF(crot, t + 1);
            const size_t k2_ = last ? PG8_KOFF(nrot, 0) : PG8_KOFF(crot, t + 2), k3_ = last ? PG8_KOFF(nrot, 1) : PG8_KOFF(crot, t + 3);
            const char* a2 = (last ? nA : cA) + k2_; const char* b2 = (last ? nB : cB) + k2_;
            const char* a3 = (last ? nA : cA) + k3_; const char* b3 = (last ? nB : cB) + k3_;
            PG8_LDB(B0, 0, 0); PG8_LDB(B1, 0, 1); PG8_SCHED; PG8_LDA(At, 0, 0); PG8_STAGE_A(PG8_SA(1, 1), a1, 1, false);
            PG8_WAIT_RLX; PG8_WAIT_L(0); PG8_BAR; PG8_MMA(0, 0, At, B0); PG8_MMA(0, 1, At, B1); PG8_BAR; PG8_SCHED;
            PG8_LDA(At, 0, 1); PG8_STAGE_B(PG8_SB(0, 0), b2); PG8_STAGE_B(PG8_SB(0, 1), b2 + bhstep); PG8_STAGE_A(PG8_SA(0, 0), a2, 0, last);
            PG8_WAIT_RLX; PG8_WAIT_L(0); PG8_BAR; PG8_MMA(1, 0, At, B0); PG8_MMA(1, 1, At, B1); PG8_BAR; PG8_SCHED;
            PG8_LDB(B0, 1, 0); PG8_LDB(B1, 1, 1); PG8_SCHED; PG8_LDA(At, 1, 0); PG8_STAGE_A(PG8_SA(0, 1), a2, 1, last);
            PG8_WAIT_V(8); PG8_WAIT_L(0); PG8_BAR; PG8_MMA(0, 0, At, B0); PG8_MMA(0, 1, At, B1); PG8_BAR; PG8_SCHED;
            PG8_LDA(At, 1, 1); PG8_STAGE_B(PG8_SB(1, 0), b3); PG8_STAGE_B(PG8_SB(1, 1), b3 + bhstep); PG8_STAGE_A(PG8_SA(1, 0), a3, 0, last);
            PG8_WAIT_V(8); PG8_WAIT_L(0); PG8_BAR; PG8_MMA(1, 0, At, B0); PG8_MMA(1, 1, At, B1); PG8_BAR; PG8_SCHED;
        }
        if constexpr (ALIGN_EPI) { if (wr == 0) PG8_BAR; }
        if constexpr (F8) { asm volatile("s_nop 15\n\ts_nop 15" ::: "memory"); PG8_SCHED; }
        E(acc, cur, wr, wc, fr, fq);
        if (!has_next) break;
        if (!E.keep(nxt)) {
#pragma unroll
            for (int a = 0; a < 2; ++a)
#pragma unroll
                for (int b = 0; b < 2; ++b)
#pragma unroll
                    for (int m = 0; m < 4; ++m)
#pragma unroll
                        for (int n = 0; n < 2; ++n) acc[a][b][m][n] = (f32x4){0.f, 0.f, 0.f, 0.f};
        }
        cur = nxt; cA = nA; cB = nB; crot = nrot; ++ui;
        if constexpr (GATHER) {
#pragma unroll
            for (int h = 0; h < 2; ++h)
#pragma unroll
                for (int i = 0; i < 2; ++i) cvo[h][i] = nvo[h][i];
        }
        if constexpr (ALIGN_EPI) { if (wr == 1) PG8_BAR; }
    }
    PG8_WAIT_V(0);
    if constexpr (!ALIGN_EPI) { if (wr == 0) PG8_BAR; }
    PG8_BAR;
#undef PG8_SA
#undef PG8_SB
#undef PG8_STAGE_A
#undef PG8_STAGE_B
#undef PG8_GLDS
#undef PG8_LDA
#undef PG8_LDB
#undef PG8_MMA
#undef PG8_WAIT_V
#undef PG8_WAIT_L
#undef PG8_WAIT_RLX
#undef PG8_KOFF
#undef PG8_BAR
#undef PG8_SCHED
#undef PG8_SETVO
}

template <int K> struct GridOrder {
    const char* A; const char* Bt; int nM, nN, nwg, G, c;
    __device__ __forceinline__ void init(const void* A_, const void* Bt_, int nM_, int nN_, int G_, int c_) { A = (const char*)A_; Bt = (const char*)Bt_; nM = nM_; nN = nN_; nwg = nM * nN; G = G_; c = c_; }
    __device__ __forceinline__ bool next(int i, GUnit& u) const {
        const long L = (long)i * G + c; if (L >= nwg) return false;
        int wgid = (int)L; { const int q = nwg / 8, r = nwg % 8, xcd = wgid % 8, off = wgid / 8; wgid = (xcd < r ? xcd * (q + 1) : r * (q + 1) + (xcd - r) * q) + off; }
        const int nig = 8 * nN, gid = wgid / nig, fm = gid * 8, gsz = (nM - fm) < 8 ? (nM - fm) : 8;
        u.pm = fm + ((wgid % nig) % gsz); u.pn = (wgid % nig) / gsz; u.e = 0; u.nrows = 256; u.row0 = u.pm * 256; u.seg = 0;
        u.A = A + (size_t)u.pm * (256 * K * 2); u.B = Bt + (size_t)u.pn * (256 * K * 2); return true;
    }
    __device__ __forceinline__ unsigned rowoff(const GUnit&, int r) const { return (unsigned)(r * K * 2); }
};
template <int K> struct GridOrder8 {
    const char* A; const char* Bt; int nM, nN, nwg, G, c;
    __device__ __forceinline__ void init(const void* A_, const void* Bt_, int nM_, int nN_, int G_, int c_) { A = (const char*)A_; Bt = (const char*)Bt_; nM = nM_; nN = nN_; nwg = nM * nN; G = G_; c = c_; }
    __device__ __forceinline__ bool next(int i, GUnit& u) const {
        const long L = (long)i * G + c; if (L >= nwg) return false;
        int wgid = (int)L; { const int q = nwg / 8, r = nwg % 8, xcd = wgid % 8, off = wgid / 8; wgid = (xcd < r ? xcd * (q + 1) : r * (q + 1) + (xcd - r) * q) + off; }
        const int nig = 8 * nN, gid = wgid / nig, fm = gid * 8, gsz = (nM - fm) < 8 ? (nM - fm) : 8;
        u.pm = fm + ((wgid % nig) % gsz); u.pn = (wgid % nig) / gsz; u.e = 0; u.nrows = 256; u.row0 = u.pm * 256; u.seg = 0;
        u.A = A + (size_t)u.pm * (256 * K); u.B = Bt + (size_t)u.pn * (256 * K); return true;
    }
    __device__ __forceinline__ unsigned rowoff(const GUnit&, int r) const { return (unsigned)(r * K); }
};
template <int K> struct PanelOrder {
    const char* A; const char* Bt; int pm, npn;
    __device__ __forceinline__ bool next(int i, GUnit& u) const {
        if (i >= npn) return false;
        u.pm = pm; u.pn = i; u.e = 0; u.nrows = 256; u.row0 = pm * 256; u.seg = 0;
        u.A = A + (size_t)pm * (256 * K * 2); u.B = Bt + (size_t)i * (256 * K * 2); return true;
    }
    __device__ __forceinline__ unsigned rowoff(const GUnit&, int r) const { return (unsigned)(r * K * 2); }
};
struct RouterOrder {
    const char* Xhi; const char* Xlo; const char* Whi; const char* Wlo; int pm, nseg;
    __device__ __forceinline__ bool next(int i, GUnit& u) const {
        if (i >= nseg) return false;
        u.pm = pm; u.pn = 0; u.e = 0; u.nrows = 256; u.row0 = pm * 256; u.seg = i;
        u.A = (i == 1 ? Xlo : Xhi) + (size_t)pm * (256 * 1024 * 2); u.B = (i == 2 ? Wlo : Whi); return true;
    }
    __device__ __forceinline__ unsigned rowoff(const GUnit&, int r) const { return (unsigned)(r * 1024 * 2); }
};
struct MergeOrder {
    const char* O[4]; const char* BrT; int G, c;
    __device__ __forceinline__ bool next(int i, GUnit& u) const {
        const int tile = c * 4 + (i >> 2); if (i >= 16 || tile >= 1024) return false;
        const int seg = i & 3; u.pm = tile >> 2; u.pn = tile & 3; u.seg = seg; u.e = 0; u.nrows = 256; u.row0 = u.pm * 256;
        const char* o = seg == 0 ? O[0] : seg == 1 ? O[1] : seg == 2 ? O[2] : O[3];
        u.A = o + (size_t)u.pm * (256 * 256 * 2); u.B = BrT + (size_t)seg * (1024 * 256 * 2) + (size_t)u.pn * (256 * 256 * 2); return true;
    }
    __device__ __forceinline__ unsigned rowoff(const GUnit&, int r) const { return (unsigned)(r * 256 * 2); }
};
template <int K, int NPN, bool E1, int ESZ = 2> struct ExpertOrder {
    const LAS int* tp; const LAS int* st; const int* rowl; const int* ident; const char* Abase; const char* W; int G, c;
    __device__ __forceinline__ bool next(int i, GUnit& u) const {
        const int ntile = __builtin_amdgcn_readfirstlane(tp[257]);
        const int total = ntile * NPN, R = (total + 7) >> 3, nW = G >> 3, pos = i * nW + (c >> 3);
        const int L = (c & 7) * R + pos;
        if (pos >= R || L >= total) return false;
        const int tile = L / NPN, pn = L % NPN;
        int lo = 0, hi = 256;
#pragma unroll
        for (int it = 0; it < 9; ++it) { const int mid = (lo + hi + 1) >> 1; if (tp[mid] <= tile) lo = mid; else hi = mid - 1; }
        const int e = __builtin_amdgcn_readfirstlane(lo), rb = __builtin_amdgcn_readfirstlane(tile - tp[lo]);
        const int cnt = __builtin_amdgcn_readfirstlane(st[e + 1] - st[e]);
        u.e = e; u.pm = rb; u.pn = pn; u.seg = 0; u.nrows = min(256, cnt - rb * 256); u.row0 = __builtin_amdgcn_readfirstlane(st[e]) + rb * 256;
        if (E1) { u.A = Abase; u.B = W + (size_t)e * WEXP_E + (size_t)pn * (256 * 1024 * ESZ); }
        else { u.A = Abase + (size_t)u.row0 * (256 * ESZ); u.B = W + (size_t)e * WEXP_E + (size_t)(512 * 1024 * 2) + (size_t)pn * (256 * 256 * ESZ); }
        return true;
    }
    __device__ __forceinline__ int rowtok(const GUnit& u, int r) const {
        const int rr = min(r, u.nrows - 1);
        const int* base = (u.e == 256) ? ident : rowl + (size_t)u.e * 65536;
        return base[u.pm * 256 + rr];
    }
    __device__ __forceinline__ unsigned rowoff(const GUnit& u, int r) const {
        if (!E1) return (unsigned)(r * K * ESZ);
        const int rr = min(r, u.nrows - 1);
        const int* base = (u.e == 256) ? ident : rowl + (size_t)u.e * 65536;
        const int tok = base[u.pm * 256 + rr];
        return (unsigned)tok * (unsigned)(K * ESZ);
    }
};
}

namespace ep {
using gm::GUnit;
struct InProj {
    static constexpr bool PERM = true; static constexpr int ADJ = 2;
    unsigned char* ws; const float* bforget;
    __device__ __forceinline__ bool keep(const GUnit&) const { return false; }
    __device__ __forceinline__ void operator()(f32x4 (&acc)[2][2][4][2], const GUnit& u, int wr, int wc, int fr, int fq) const {
        const int pn = u.pn;
        int mode = 0; float scale = 1.f; bf16* out; int ld = 256;
        const bool ktile = (pn < 12) && (pn % 3 == 1);
        if (pn < 12) { const int br = pn / 3, kind = pn % 3; const int slot = (kind == 0) ? br : 4 + 2 * br + (kind - 1);
            out = (bf16*)(ws + A_TB + (size_t)slot * (32 * MiB));
            if (kind < 2) mode = (br == 0 || br == 3) ? 1 : (br == 1 ? 2 : 0);
            if (kind == 0) scale = (br == 1) ? 0.17677669529663687f * LOG2E : 0.125f * LOG2E; }
        else if (pn == 12) { out = (bf16*)(ws + A_TB + (size_t)12 * (32 * MiB)); mode = 1; scale = 0.125f; }
        else if (pn == 13) { out = (bf16*)(ws + A_IDXK); mode = 4; ld = 64; }
        else { out = (bf16*)(ws + A_GATES) + (pn - 14) * 256; mode = 3; ld = 4096; }
        float irev[2][4];
#pragma unroll
        for (int bj = 0; bj < 2; ++bj) { const int c8 = wc * 64 + fq * 16 + bj * 8; const int j0 = (mode == 2) ? ((c8 & 31) >> 1) : ((c8 & 63) >> 1); const float ih = (mode == 2) ? (1.0f / 16.0f) : (1.0f / 32.0f);
#pragma unroll
            for (int jj = 0; jj < 4; ++jj) irev[bj][jj] = __builtin_amdgcn_exp2f(-(float)(j0 + jj) * ih * 13.287712379549449f) * 0.15915494309189535f; }
#pragma unroll
        for (int ai = 0; ai < 2; ++ai)
#pragma unroll
            for (int m = 0; m < 4; ++m) {
                const int row = u.pm * 256 + ai * 128 + wr * 64 + m * 16 + fr, pos = row & (SEQ - 1);
#pragma unroll
                for (int bj = 0; bj < 2; ++bj) {
                    const int c8 = wc * 64 + fq * 16 + bj * 8;
                    f32x4 v0 = acc[ai][bj][m][0], v1 = acc[ai][bj][m][1];
                    if (mode == 4) {
                        if (c8 == 64) {
                            const f32x4 bf = *(const f32x4*)bforget;
                            f32x4 lf;
#pragma unroll
                            for (int i = 0; i < 4; ++i) { const float z = v0[i] + bf[i]; lf[i] = fminf(z, 0.f) - log1pf(__expf(-fabsf(z))); }
                            *(f32x4*)(ws + WS_LOGF + (size_t)row * 16) = lf;
                            *(f32x4*)(ws + WS_IDXW + (size_t)row * 16) = v1 * 0.5f;
                        }
                        if (c8 >= 64) continue;
                    }
                    if (mode == 1 || mode == 2 || mode == 4) {
                        const float fp = (float)pos;
                        float cs[4], sn[4];
#pragma unroll
                        for (int jj = 0; jj < 4; ++jj) { const float rv = __builtin_amdgcn_fractf(fp * irev[bj][jj]); cs[jj] = __builtin_amdgcn_cosf(rv); sn[jj] = __builtin_amdgcn_sinf(rv); }
                        f32x4 a, b;
                        a[0] = v0[0] * cs[0] - v0[1] * sn[0]; a[1] = v0[0] * sn[0] + v0[1] * cs[0];
                        a[2] = v0[2] * cs[1] - v0[3] * sn[1]; a[3] = v0[2] * sn[1] + v0[3] * cs[1];
                        b[0] = v1[0] * cs[2] - v1[1] * sn[2]; b[1] = v1[0] * sn[2] + v1[1] * cs[2];
                        b[2] = v1[2] * cs[3] - v1[3] * sn[3]; b[3] = v1[2] * sn[3] + v1[3] * cs[3];
                        v0 = a; v1 = b;
                    } else if (mode == 3) {
#pragma unroll
                        for (int i = 0; i < 4; ++i) { v0[i] = fminf(fmaxf(v0[i], -60.f), 60.f); v1[i] = fminf(fmaxf(v1[i], -60.f), 60.f); }
                    }
                    if (mode == 3) {
                        int w0 = 0, w1 = 0;
                        w0 = __builtin_amdgcn_cvt_pk_fp8_f32(v0[0], v0[1], w0, false); w0 = __builtin_amdgcn_cvt_pk_fp8_f32(v0[2], v0[3], w0, true);
                        w1 = __builtin_amdgcn_cvt_pk_fp8_f32(v1[0], v1[1], w1, false); w1 = __builtin_amdgcn_cvt_pk_fp8_f32(v1[2], v1[3], w1, true);
                        *(u32x2*)((unsigned char*)(ws + A_GATES) + (size_t)row * 4096 + (pn - 14) * 256 + c8) = (u32x2){(unsigned)w0, (unsigned)w1};
                        continue;
                    }
                    v0 = v0 * scale; v1 = v1 * scale;
                    u32x4 w; w.x = pk2(v0[0], v0[1]); w.y = pk2(v0[2], v0[3]); w.z = pk2(v1[0], v1[1]); w.w = pk2(v1[2], v1[3]);
                    if (ktile) {
                        const size_t tix = ((size_t)(row >> 11) * 4 + (c8 >> 6)) * 32 + (pos >> 6);
                        *(u32x4*)(out + tix * 4096 + ((c8 & 63) >> 3) * 512 + (pos & 63) * 8) = w;
                    } else *(u32x4*)(out + (size_t)row * ld + c8) = w;
                }
            }
    }
};
struct InGate {
    static constexpr bool PERM = true; static constexpr int ADJ = 2;
    unsigned char* gates;
    __device__ __forceinline__ bool keep(const GUnit&) const { return false; }
    __device__ __forceinline__ void operator()(f32x4 (&acc)[2][2][4][2], const GUnit& u, int wr, int wc, int fr, int fq) const {
#pragma unroll
        for (int ai = 0; ai < 2; ++ai)
#pragma unroll
            for (int m = 0; m < 4; ++m) {
                const int row = u.pm * 256 + ai * 128 + wr * 64 + m * 16 + fr;
                int w[4];
#pragma unroll
                for (int bj = 0; bj < 2; ++bj)
#pragma unroll
                    for (int n = 0; n < 2; ++n) { f32x4 v = acc[ai][bj][m][n];
#pragma unroll
                        for (int i = 0; i < 4; ++i) v[i] = __builtin_amdgcn_fmed3f(v[i], -86.5f, 86.5f);
                        int t = 0; t = __builtin_amdgcn_cvt_pk_fp8_f32(v[0], v[1], t, false); t = __builtin_amdgcn_cvt_pk_fp8_f32(v[2], v[3], t, true); w[2 * bj + n] = t; }
                *(u32x4*)(gates + (size_t)row * 4096 + u.pn * 256 + wc * 64 + fq * 16) = (u32x4){(unsigned)w[0], (unsigned)w[1], (unsigned)w[2], (unsigned)w[3]};
            }
    }
};
struct Merge {
    static constexpr bool PERM = true; static constexpr int ADJ = 2;
    const unsigned char* gates; bf16* merged;
    __device__ __forceinline__ bool keep(const GUnit& nx) const { return nx.seg != 0; }
    __device__ __forceinline__ void operator()(f32x4 (&acc)[2][2][4][2], const GUnit& u, int wr, int wc, int fr, int fq) const {
        const int seg = u.seg;
        const int c16 = u.pn * 256 + wc * 64 + fq * 16;
        const unsigned char* gbase = gates + (size_t)(u.pm * 256 + wr * 64 + fr) * 4096 + seg * 1024 + c16;
        constexpr int GD = 3;
        u32x4 qa[GD], qb[GD], ga, gb;
#define MG_ROWOFF(g_) ((size_t)(((g_) >> 2) * 128 + ((g_) & 3) * 16) * 4096)
#pragma unroll
        for (int d = 0; d < GD; ++d) { qa[d] = *(const u32x4*)(gbase + MG_ROWOFF(d)); qb[d] = (seg < 3) ? *(const u32x4*)(gbase + MG_ROWOFF(d) + 1024) : qa[d]; }
#pragma unroll
        for (int g = 0; g < 8; ++g) {
            const int ai = g >> 2, m = g & 3;
            ga = qa[g % GD]; gb = qb[g % GD];
            if (g + GD < 8) { qa[g % GD] = *(const u32x4*)(gbase + MG_ROWOFF(g + GD)); qb[g % GD] = (seg < 3) ? *(const u32x4*)(gbase + MG_ROWOFF(g + GD) + 1024) : qa[g % GD]; }
            const int row = u.pm * 256 + ai * 128 + wr * 64 + m * 16 + fr;
#pragma unroll
            for (int bj = 0; bj < 2; ++bj) {
                const unsigned gx = bj ? ga.z : ga.x, gy = bj ? ga.w : ga.y, hx = bj ? gb.z : gb.x, hy = bj ? gb.w : gb.y;
                const f32x2 a0 = __builtin_amdgcn_cvt_pk_f32_fp8((int)gx, false), a1 = __builtin_amdgcn_cvt_pk_f32_fp8((int)gx, true), a2 = __builtin_amdgcn_cvt_pk_f32_fp8((int)gy, false), a3 = __builtin_amdgcn_cvt_pk_f32_fp8((int)gy, true);
                f32x4 r0 = {a0[0], a0[1], a1[0], a1[1]}, r1 = {a2[0], a2[1], a3[0], a3[1]};
#pragma unroll
                for (int i = 0; i < 4; ++i) { r0[i] = __builtin_amdgcn_rcpf(1.0f + __builtin_amdgcn_exp2f(r0[i])); r1[i] = __builtin_amdgcn_rcpf(1.0f + __builtin_amdgcn_exp2f(r1[i])); }
                if (seg < 3) {
                    const f32x2 b0 = __builtin_amdgcn_cvt_pk_f32_fp8((int)hx, false), b1 = __builtin_amdgcn_cvt_pk_f32_fp8((int)hx, true), b2 = __builtin_amdgcn_cvt_pk_f32_fp8((int)hy, false), b3 = __builtin_amdgcn_cvt_pk_f32_fp8((int)hy, true);
                    const f32x4 d0 = {b0[0], b0[1], b1[0], b1[1]}, d1 = {b2[0], b2[1], b3[0], b3[1]};
#pragma unroll
                    for (int i = 0; i < 4; ++i) { r0[i] = r0[i] * (1.0f + __builtin_amdgcn_exp2f(d0[i])); r1[i] = r1[i] * (1.0f + __builtin_amdgcn_exp2f(d1[i])); }
                    acc[ai][bj][m][0] = acc[ai][bj][m][0] * r0; acc[ai][bj][m][1] = acc[ai][bj][m][1] * r1;
                } else {
                    const f32x4 v0 = acc[ai][bj][m][0] * r0, v1 = acc[ai][bj][m][1] * r1;
                    u32x4 w; w.x = pk2(v0[0], v0[1]); w.y = pk2(v0[2], v0[3]); w.z = pk2(v1[0], v1[1]); w.w = pk2(v1[2], v1[3]);
                    *(u32x4*)(merged + (size_t)row * 1024 + c16 + 8 * bj) = w;
                }
            }
        }
#undef MG_ROWOFF
    }
};
struct OutPre {
    static constexpr bool PERM = true; static constexpr int ADJ = 1;
    const bf16* x; bf16* pre;
    __device__ __forceinline__ bool keep(const GUnit&) const { return false; }
    __device__ __forceinline__ void operator()(f32x4 (&acc)[2][2][4][2], const GUnit& u, int wr, int wc, int fr, int fq) const {
        const size_t base = (size_t)(u.pm * 256 + wr * 64 + fr) * 1024 + u.pn * 256 + wc * 64 + fq * 8;
        u32x4 nx[2], cx[2];
#pragma unroll
        for (int bj = 0; bj < 2; ++bj) nx[bj] = *(const u32x4*)(x + base + bj * 32);
#pragma unroll
        for (int g = 0; g < 8; ++g) {
            const int ai = g >> 2, m = g & 3;
            const size_t off = base + (size_t)(ai * 128 + m * 16) * 1024;
#pragma unroll
            for (int bj = 0; bj < 2; ++bj) cx[bj] = nx[bj];
            if (g < 7) { const size_t o2 = base + (size_t)(((g + 1) >> 2) * 128 + ((g + 1) & 3) * 16) * 1024;
#pragma unroll
                for (int bj = 0; bj < 2; ++bj) nx[bj] = *(const u32x4*)(x + o2 + bj * 32); }
#pragma unroll
            for (int bj = 0; bj < 2; ++bj) { const f32x4 v0 = (f32x4){bflo(cx[bj].x), bfhi(cx[bj].x), bflo(cx[bj].y), bfhi(cx[bj].y)} * ALPHA + acc[ai][bj][m][0],
                                                         v1 = (f32x4){bflo(cx[bj].z), bfhi(cx[bj].z), bflo(cx[bj].w), bfhi(cx[bj].w)} * ALPHA + acc[ai][bj][m][1];
                u32x4 w; w.x = pk2(v0[0], v0[1]); w.y = pk2(v0[2], v0[3]); w.z = pk2(v1[0], v1[1]); w.w = pk2(v1[2], v1[3]);
                *(u32x4*)(pre + off + bj * 32) = w; }
        }
    }
};
struct Router {
    static constexpr bool PERM = false; static constexpr int ADJ = 0;
    float* sc; int last;
    __device__ __forceinline__ bool keep(const GUnit& nx) const { return nx.seg != 0; }
    __device__ __forceinline__ void operator()(f32x4 (&acc)[2][2][4][2], const GUnit& u, int wr, int wc, int fr, int fq) const {
        if (u.seg != last) return;
#pragma unroll
        for (int ai = 0; ai < 2; ++ai)
#pragma unroll
            for (int m = 0; m < 4; ++m) {
                const size_t off = (size_t)(u.pm * 256 + ai * 128 + wr * 64 + m * 16 + fr) * 256 + wc * 32 + 4 * fq;
#pragma unroll
                for (int bj = 0; bj < 2; ++bj)
#pragma unroll
                    for (int n = 0; n < 2; ++n) { f32x4 v = acc[ai][bj][m][n];
#pragma unroll
                        for (int i = 0; i < 4; ++i) v[i] = sigmoidf_(v[i]);
                        *(f32x4*)(sc + off + bj * 128 + n * 16) = v; }
            }
    }
};
struct E1 {
    static constexpr bool PERM = true; static constexpr int ADJ = 2;
    bf16* H;
    __device__ __forceinline__ bool keep(const GUnit&) const { return false; }
    __device__ __forceinline__ void operator()(f32x4 (&acc)[2][2][4][2], const GUnit& u, int wr, int wc, int fr, int fq) const {
#pragma unroll
        for (int ai = 0; ai < 2; ++ai)
#pragma unroll
            for (int m = 0; m < 4; ++m) {
                const int r = ai * 128 + wr * 64 + m * 16 + fr;
                if (r < u.nrows) {
                    int w[2] = {0, 0};
#pragma unroll
                    for (int bj = 0; bj < 2; ++bj)
#pragma unroll
                        for (int n = 0; n < 2; ++n) { const f32x4 v = acc[ai][bj][m][n];
                            const float h0 = v[0] * sigmoidf_(v[0]) * v[1] * H_SCALE, h1 = v[2] * sigmoidf_(v[2]) * v[3] * H_SCALE;
                            if (n == 0) w[bj] = __builtin_amdgcn_cvt_pk_fp8_f32(h0, h1, w[bj], false); else w[bj] = __builtin_amdgcn_cvt_pk_fp8_f32(h0, h1, w[bj], true); }
                    *(u32x2*)((unsigned char*)H + (size_t)(u.row0 + r) * 256 + u.pn * 128 + wc * 32 + fq * 8) = (u32x2){(unsigned)w[0], (unsigned)w[1]};
                }
            }
    }
};
struct E2 {
    static constexpr bool PERM = true; static constexpr int ADJ = 2;
    bf16* Y; int off; unsigned char* dump;
    __device__ __forceinline__ bool keep(const GUnit&) const { return false; }
    __device__ __forceinline__ void operator()(f32x4 (&acc)[2][2][4][2], const GUnit& u, int wr, int wc, int fr, int fq) const {
#pragma unroll
        for (int ai = 0; ai < 2; ++ai)
#pragma unroll
            for (int m = 0; m < 4; ++m) {
                const int r = ai * 128 + wr * 64 + m * 16 + fr;
                {
                    int w[4];
#pragma unroll
                    for (int bj = 0; bj < 2; ++bj)
#pragma unroll
                        for (int n = 0; n < 2; ++n) { const f32x4 v = acc[ai][bj][m][n]; int t = 0;
                            t = __builtin_amdgcn_cvt_pk_fp8_f32(v[0], v[1], t, false); t = __builtin_amdgcn_cvt_pk_fp8_f32(v[2], v[3], t, true); w[2 * bj + n] = t; }
                    unsigned char* const dst = (r < u.nrows) ? (unsigned char*)Y + (size_t)(u.row0 + r) * 1024 : dump + (size_t)r * 1024;
                    *(u32x4*)(dst + u.pn * 256 + wc * 64 + fq * 16) = (u32x4){(unsigned)w[0], (unsigned)w[1], (unsigned)w[2], (unsigned)w[3]};
                }
            }
    }
};
}

namespace att {
constexpr int PITCH = 256, KVBLK = 64, SLOTB = 8192;
constexpr int NSLOT = 5;
constexpr int L_K = 0, L_V = NSLOT * SLOTB, L_WS = 2 * NSLOT * SLOTB, L_OST = L_WS + 2048, L_KM = L_OST + 8 * 4096, L_C2 = L_KM + 8192, L_END = L_C2 + 8192;
static_assert(L_END <= LX_BASE, "attention lds");
typedef LAS const char* lds_cptr;
__device__ __forceinline__ int crow(int r, int hi) { return (r & 3) + 8 * (r >> 2) + 4 * hi; }
__device__ __forceinline__ void cmask(f32x16& p0, f32x16& p1, int jb, int qrel, int hi) {
    const float NEG = -INFINITY; const int kb = 64 * jb + 4 * hi;
#pragma unroll
    for (int r = 0; r < 16; ++r) { const int kv = kb + (r & 3) + 8 * (r >> 2); if (kv > qrel) p0[r] = NEG; if (kv + 32 > qrel) p1[r] = NEG; }
}
__device__ __forceinline__ void glds16(const void* gsrc, unsigned lds_dst) { unsigned keep;
    asm volatile("s_mov_b32 %0, m0\n\ts_mov_b32 m0, %2\n\ts_nop 0\n\tglobal_load_lds_dwordx4 %1, off\n\ts_mov_b32 m0, %0" : "=&s"(keep) : "v"(gsrc), "s"(lds_dst) : "memory"); }
#define ATT_WAIT_BAR(N) asm volatile("s_waitcnt vmcnt(" #N ") lgkmcnt(0)\n\ts_barrier" ::: "memory")
template <int D0A, int D0B> __device__ __forceinline__ void qkt(f32x16& p0, f32x16& p1, lds_cptr Kslot, const bf16x8* qr, int r32, int hi, const f32x16& z) {
    const lds_cptr kb = Kslot + hi * 1024 + r32 * 16;
#pragma unroll
    for (int d0 = D0A; d0 < D0B; ++d0) {
        const bf16x8 b0 = *(const LAS bf16x8*)(kb + d0 * 2048);
        const bf16x8 b1 = *(const LAS bf16x8*)(kb + d0 * 2048 + 512);
        if (d0 == D0A) { p0 = __builtin_amdgcn_mfma_f32_32x32x16_bf16(b0, qr[d0], z, 0, 0, 0); p1 = __builtin_amdgcn_mfma_f32_32x32x16_bf16(b1, qr[d0], z, 0, 0, 0); }
        else { p0 = __builtin_amdgcn_mfma_f32_32x32x16_bf16(b0, qr[d0], p0, 0, 0, 0); p1 = __builtin_amdgcn_mfma_f32_32x32x16_bf16(b1, qr[d0], p1, 0, 0, 0); }
    }
}
__device__ __forceinline__ float rowmax(const f32x16& p0, const f32x16& p1) {
    float a = fmaxf(fmaxf(p0[0], p0[1]), p1[0]), b = fmaxf(fmaxf(p0[2], p0[3]), p1[1]); a = fmaxf(fmaxf(a, p1[2]), p1[3]);
#pragma unroll
    for (int r = 4; r < 16; r += 4) { a = fmaxf(fmaxf(a, p0[r]), p0[r + 1]); b = fmaxf(fmaxf(b, p0[r + 2]), p0[r + 3]); a = fmaxf(fmaxf(a, p1[r]), p1[r + 1]); b = fmaxf(fmaxf(b, p1[r + 2]), p1[r + 3]); }
    const float m = fmaxf(a, b);
    const auto rr = __builtin_amdgcn_permlane32_swap(__float_as_uint(m), __float_as_uint(m), false, false);
    return fmaxf(__uint_as_float(rr[0]), __uint_as_float(rr[1]));
}
struct VFrag { s16x4 lo[8], hi[8]; };
__device__ __forceinline__ void load_v(VFrag& v, int vb) {
#pragma unroll
    for (int d0 = 0; d0 < 2; ++d0)
#pragma unroll
        for (int ks = 0; ks < 4; ++ks) {
            asm volatile("ds_read_b64_tr_b16 %0,%1 offset:%c2" : "=&v"(v.lo[d0 * 4 + ks]) : "v"(vb), "i"(d0 * 4096 + ks * 1024) : "memory");
            asm volatile("ds_read_b64_tr_b16 %0,%1 offset:%c2" : "=&v"(v.hi[d0 * 4 + ks]) : "v"(vb), "i"(d0 * 4096 + ks * 1024 + 512) : "memory"); }
    asm volatile("s_waitcnt lgkmcnt(0)" ::: "memory");
    __builtin_amdgcn_sched_barrier(0);
}
#define ATT_PK(v, k) (bf16x8){v.lo[k][0], v.lo[k][1], v.lo[k][2], v.lo[k][3], v.hi[k][0], v.hi[k][1], v.hi[k][2], v.hi[k][3]}
__device__ __forceinline__ void pv_mm(f32x16* o, const VFrag& v, const u32x4& pw0, const u32x4& pw1, const u32x4& pw2, const u32x4& pw3) {
#pragma unroll
    for (int d0 = 0; d0 < 2; ++d0) {
        o[d0] = __builtin_amdgcn_mfma_f32_32x32x16_bf16(__builtin_bit_cast(bf16x8, pw0), ATT_PK(v, d0 * 4 + 0), o[d0], 0, 0, 0);
        o[d0] = __builtin_amdgcn_mfma_f32_32x32x16_bf16(__builtin_bit_cast(bf16x8, pw1), ATT_PK(v, d0 * 4 + 1), o[d0], 0, 0, 0);
        o[d0] = __builtin_amdgcn_mfma_f32_32x32x16_bf16(__builtin_bit_cast(bf16x8, pw2), ATT_PK(v, d0 * 4 + 2), o[d0], 0, 0, 0);
        o[d0] = __builtin_amdgcn_mfma_f32_32x32x16_bf16(__builtin_bit_cast(bf16x8, pw3), ATT_PK(v, d0 * 4 + 3), o[d0], 0, 0, 0);
    }
}
constexpr float THR = 8.0f;
__device__ __forceinline__ void softmax_tile(f32x16& p0, f32x16& p1, float& m, float mu, float& minit, float& l, f32x16* o, f32x16& negm, LAS float* wsf, int r32, int hi, u32x4& pw0, u32x4& pw1, u32x4& pw2, u32x4& pw3) {
    const float d = m - mu;
    if (__any(d != 0.f)) {
#pragma unroll
        for (int r = 0; r < 16; ++r) { p0[r] -= d; p1[r] -= d; } }
    const float rm = rowmax(p0, p1);
    const bool fin = rm > -INFINITY, fresh = fin && (minit == 0.f);
    if (__any(fresh || rm > THR)) {
        const float dl = fresh ? rm : (fin ? fmaxf(rm, 0.f) : 0.f);
        m += dl;
#pragma unroll
        for (int r = 0; r < 16; ++r) { p0[r] -= dl; p1[r] -= dl; }
        const float alpha = fresh ? 1.0f : __builtin_amdgcn_exp2f(-dl);
        l *= alpha;
        if (hi == 0) wsf[r32] = alpha;
        asm volatile("s_waitcnt lgkmcnt(0)" ::: "memory");
#pragma unroll
        for (int r = 0; r < 16; ++r) { const float f = wsf[crow(r, hi)]; o[0][r] *= f; o[1][r] *= f; }
        asm volatile("s_waitcnt lgkmcnt(0)" ::: "memory");
#pragma unroll
        for (int r = 0; r < 16; ++r) negm[r] = -m;
    }
    minit = fin ? 1.0f : minit;
    float s = 0.f;
#pragma unroll
    for (int r = 0; r < 16; ++r) { p0[r] = __builtin_amdgcn_exp2f(p0[r]); p1[r] = __builtin_amdgcn_exp2f(p1[r]); s += p0[r] + p1[r]; }
    l += s;
    pw0 = (u32x4){pk2(p0[0], p0[1]), pk2(p0[2], p0[3]), pk2(p0[4], p0[5]), pk2(p0[6], p0[7])};
    pw1 = (u32x4){pk2(p0[8], p0[9]), pk2(p0[10], p0[11]), pk2(p0[12], p0[13]), pk2(p0[14], p0[15])};
    pw2 = (u32x4){pk2(p1[0], p1[1]), pk2(p1[2], p1[3]), pk2(p1[4], p1[5]), pk2(p1[6], p1[7])};
    pw3 = (u32x4){pk2(p1[8], p1[9]), pk2(p1[10], p1[11]), pk2(p1[12], p1[13]), pk2(p1[14], p1[15])};
}
struct Aux { unsigned char* ws; const float* dlam; const float* subln; float lam_init; };
template <int MODE>
__device__ __forceinline__ void attn_unit(int b, int h, int qb, const Aux& ax, LAS unsigned char* lds) {
    constexpr int QS = MODE == 0 ? 0 : MODE == 1 ? 1 : MODE == 2 ? 2 : 3, KS = 4 + 2 * QS, VS = 5 + 2 * QS;
    const bf16* Q = (const bf16*)(ax.ws + A_TB + (size_t)QS * (32 * MiB)); const bf16* K = (const bf16*)(ax.ws + A_TB + (size_t)KS * (32 * MiB));
    const bf16* V = (const bf16*)(ax.ws + A_TB + (size_t)VS * (32 * MiB)); bf16* O = (bf16*)(ax.ws + A_O + (size_t)QS * (32 * MiB));
    int tid_ = threadIdx.x; asm volatile("" : "+v"(tid_));
    const int tid = tid_, lane = tid & 63, r32 = lane & 31, hi = lane >> 5; const int wid = __builtin_amdgcn_readfirstlane(tid >> 6);
    const long rowbase = (long)b * SEQ; const int q0 = qb * 256;
    const bf16* Qw = Q + (rowbase + q0 + wid * 32) * PITCH + h * 64;
    const bf16* Kh = K + rowbase * PITCH + h * 64, *Vh = V + rowbase * PITCH + h * 64;
    const unsigned lds0 = (unsigned)(uintptr_t)lds;
    LAS float* wsf = (LAS float*)(lds + L_WS) + wid * 64;
    const bf16* ksrc = K + (((size_t)b * 4 + h) * 32) * 4096 + wid * 512 + lane * 8;
    const bf16* vsrc = Vh + (long)(16 * (wid & 3) + (lane >> 2)) * PITCH + (wid >> 2) * 32 + (lane & 3) * 8;
    const unsigned kdst = lds0 + L_K + wid * 1024, vdst = lds0 + L_V + wid * 1024;
#define DMA_K(t, slot) glds16(ksrc + (long)(t) * 4096, (unsigned)__builtin_amdgcn_readfirstlane(kdst + (slot)))
#define DMA_V(t, slot) glds16(vsrc + (long)(t) * KVBLK * PITCH, (unsigned)__builtin_amdgcn_readfirstlane(vdst + (slot)))
    const int vb0 = (int)(lds0 + L_V) + ((lane >> 4) & 1) * 32 + (lane & 3) * 8 + (4 * hi + ((lane & 15) >> 2)) * 64;
    const lds_cptr Kbase = (lds_cptr)(lds + L_K);
    const int NT = (q0 + 256) / KVBLK;
    DMA_K(0, 0); DMA_V(0, 0); DMA_K(1, SLOTB); DMA_V(1, SLOTB); DMA_K(2, 2 * SLOTB); DMA_V(2, 2 * SLOTB); DMA_K(3, 3 * SLOTB); DMA_V(3, 3 * SLOTB);
    if (NT > 4) { DMA_K(4, 4 * SLOTB); DMA_V(4, 4 * SLOTB); }
    bf16x8 qr[4];
#pragma unroll
    for (int d0 = 0; d0 < 4; ++d0) qr[d0] = *(const bf16x8*)(&Qw[(long)r32 * PITCH + d0 * 16 + hi * 8]);
    const int qrel = wid * 32 + r32;
    unsigned allow = 0xffu;
    if (MODE == 0 && qb >= 4) {
        if (wid == 0) { const int n = lane & 7, c = lane >> 3;
            const u32x4 kv = *(const u32x4*)((const bf16*)(ax.ws + WS_KMEAN) + (((size_t)b * 4 + h) * 8 + n) * 64 + c * 8);
            *(LAS u32x4*)(lds + L_KM + c * 1024 + n * 16) = kv; }
        asm volatile("s_waitcnt lgkmcnt(0)\n\ts_barrier" ::: "memory");
        f32x16 g0, g1; { const f32x16 zz = {}; qkt<0, 4>(g0, g1, (lds_cptr)(lds + L_KM), qr, r32, hi, zz); }
        float own[4], oth[4], g[8];
#pragma unroll
        for (int i = 0; i < 4; ++i) { own[i] = g0[i]; oth[i] = __shfl_xor(own[i], 32); }
#pragma unroll
        for (int i = 0; i < 4; ++i) { g[i] = hi ? oth[i] : own[i]; g[4 + i] = hi ? own[i] : oth[i]; }
        allow = 0u;
#pragma unroll
        for (int n = 0; n < 8; ++n) { int rank = 0;
#pragma unroll
            for (int mm = 0; mm < 8; ++mm) { if (mm != n) rank += (mm < qb && (g[mm] > g[n] || (g[mm] == g[n] && mm < n))) ? 1 : 0; }
            if (n < qb && rank < 3) allow |= 1u << n; }
    }
    const unsigned long long* mrow = (MODE == 3) ? (const unsigned long long*)(ax.ws + A_MASK) + (size_t)(rowbase + q0 + qrel) * 32 : nullptr;
    LAS float* c2l = (LAS float*)(lds + L_C2);
    if (MODE == 2) {
        const float* c2h = (const float*)(ax.ws + WS_C2) + ((size_t)b * 4 + h) * SEQ;
        if (4 * tid < q0 + 256) *(LAS f32x4*)(c2l + 4 * tid) = *(const f32x4*)(c2h + 4 * tid);
    }
    float m0 = 0.f, l0 = 0.f, m1 = 0.f, l1 = 0.f, mi0 = 0.f, mi1 = 0.f, mu_c = 0.f;
    f32x16 o[2], o2[2], negm0 = f32x16{}; o[0] = f32x16{}; o[1] = f32x16{}; o2[0] = f32x16{}; o2[1] = f32x16{};
#define ATT_ACTIVE(t_) ({ const int bd_ = (t_) - (NT - 4); bool a_ = !(bd_ >= 0 && 64 * bd_ > 32 * wid + 31); if (MODE == 0 && a_ && bd_ < 0) a_ = __any((allow >> ((t_) >> 2)) & 1u) != 0; a_; })
#define ATT_MASKS(S0, S1, t_) do { const int bd_ = (t_) - (NT - 4); \
        if (MODE == 2) { const LAS f32x4* cp_ = (const LAS f32x4*)(c2l + (t_) * KVBLK + 4 * hi); f32x4 cb_[8]; \
            _Pragma("unroll") for (int j_ = 0; j_ < 8; ++j_) cb_[j_] = cp_[2 * j_]; \
            _Pragma("unroll") for (int r_ = 0; r_ < 16; ++r_) { S0[r_] -= cb_[(r_ >> 2)][r_ & 3]; S1[r_] -= cb_[4 + (r_ >> 2)][r_ & 3]; } } \
        if (MODE == 3) { const unsigned ml_ = (unsigned)mk_c >> (4 * hi), mh_ = (unsigned)(mk_c >> 32) >> (4 * hi); \
            _Pragma("unroll") for (int r_ = 0; r_ < 16; ++r_) { const int cb2_ = (r_ & 3) + 8 * (r_ >> 2); if (!((ml_ >> cb2_) & 1u)) S0[r_] = -INFINITY; if (!((mh_ >> cb2_) & 1u)) S1[r_] = -INFINITY; } } \
        else if (bd_ >= 0) cmask(S0, S1, bd_, qrel, hi); \
        if (MODE == 0 && bd_ < 0 && !((allow >> ((t_) >> 2)) & 1u)) { _Pragma("unroll") for (int r_ = 0; r_ < 16; ++r_) { S0[r_] = -INFINITY; S1[r_] = -INFINITY; } } } while (0)
#define ATT_SLOT(t_) ((int)((unsigned)(t_) % (unsigned)NSLOT) * SLOTB)
#define ATT_END2(t_) do { if ((t_) + 2 < NT) { ATT_WAIT_BAR(0); \
            if ((t_) + 5 < NT) { const int s5_ = ATT_SLOT((t_) + 5); DMA_K((t_) + 5, s5_); DMA_V((t_) + 5, s5_); } \
            if ((t_) + 6 < NT) { const int s6_ = ATT_SLOT((t_) + 6); DMA_K((t_) + 6, s6_); DMA_V((t_) + 6, s6_); } } } while (0)
    unsigned long long mk_c = 0ull, mk_n = 0ull;
    if (NT > 4) ATT_WAIT_BAR(4); else ATT_WAIT_BAR(2);
    bool act = ATT_ACTIVE(0);
    f32x16 sA0, sA1, sB0, sB1; u32x4 pa0, pa1, pa2, pa3, pb0, pb1, pb2, pb3;
    if (MODE == 3) mk_c = mrow[0];
    const f32x16 zz = {}; f32x16 ndum = {};
    if (MODE == 1) { if (act) qkt<0, 2>(sA0, sA1, Kbase, qr, r32, hi, zz); }
    else { if (act) qkt<0, 4>(sA0, sA1, Kbase, qr, r32, hi, negm0); }
#define ATT_STEP(C0, C1, N0, N1, t_) do { \
        const bool actn_ = ((t_) + 1 < NT) && ATT_ACTIVE((t_) + 1); const float mu_n_ = m0; \
        if (actn_) qkt<0, 4>(N0, N1, Kbase + ATT_SLOT((t_) + 1), qr, r32, hi, negm0); \
        if (MODE == 3) mk_n = ((t_) + 1 < NT) ? mrow[(t_) + 1] : 0ull; \
        __builtin_amdgcn_sched_barrier(0); \
        if (act) { ATT_MASKS(C0, C1, t_); softmax_tile(C0, C1, m0, mu_c, mi0, l0, o, negm0, wsf, r32, hi, pa0, pa1, pa2, pa3); \
            VFrag vf_; load_v(vf_, vb0 + ATT_SLOT(t_)); pv_mm(o, vf_, pa0, pa1, pa2, pa3); } \
        act = actn_; mk_c = mk_n; mu_c = mu_n_; } while (0)
    if (MODE != 1) {
        for (int t = 0; t < NT; t += 2) { ATT_STEP(sA0, sA1, sB0, sB1, t); ATT_STEP(sB0, sB1, sA0, sA1, t + 1); ATT_END2(t); }
    } else {
#define ATT_DSTEP(t_) do {                    \
            if (act) qkt<2, 4>(sB0, sB1, Kbase + ATT_SLOT(t_), qr, r32, hi, zz); \
            __builtin_amdgcn_sched_barrier(0); \
            if (act) { ATT_MASKS(sA0, sA1, t_); softmax_tile(sA0, sA1, m0, 0.f, mi0, l0, o, ndum, wsf, r32, hi, pa0, pa1, pa2, pa3); } \
            const bool actn_ = ((t_) + 1 < NT) && ATT_ACTIVE((t_) + 1); \
            if (actn_) qkt<0, 2>(sA0, sA1, Kbase + ATT_SLOT((t_) + 1), qr, r32, hi, zz); \
            __builtin_amdgcn_sched_barrier(0); \
            if (act) { ATT_MASKS(sB0, sB1, t_); softmax_tile(sB0, sB1, m1, 0.f, mi1, l1, o2, ndum, wsf, r32, hi, pb0, pb1, pb2, pb3); \
                VFrag vf_; load_v(vf_, vb0 + ATT_SLOT(t_)); pv_mm(o, vf_, pa0, pa1, pa2, pa3); pv_mm(o2, vf_, pb0, pb1, pb2, pb3); } \
            act = actn_; } while (0)
        for (int t = 0; t < NT; t += 2) { ATT_DSTEP(t); ATT_DSTEP(t + 1); ATT_END2(t); }
#undef ATT_DSTEP
    }
#undef ATT_SLOT
#undef ATT_END2
#undef ATT_STEP
#undef ATT_MASKS
#undef ATT_ACTIVE
    l0 += __shfl_xor(l0, 32);
    if (MODE == 1) l1 += __shfl_xor(l1, 32);
    if (hi == 0) { wsf[r32] = 1.0f / l0; if (MODE == 1) wsf[32 + r32] = 1.0f / l1; }
    asm volatile("s_waitcnt lgkmcnt(0)" ::: "memory");
    float lam = 0.f;
    if (MODE == 1) { float s1 = 0.f, s2 = 0.f;
        for (int i = 0; i < 32; ++i) { s1 += ax.dlam[i] * ax.dlam[32 + i]; s2 += ax.dlam[64 + i] * ax.dlam[96 + i]; }
        lam = __expf(s1) - __expf(s2) + ax.lam_init; }
    bf16* Ow = O + (rowbase + q0 + wid * 32) * PITCH + h * 64;
    {   LAS bf16* stg = (LAS bf16*)(lds + L_OST) + wid * 2048;
#pragma unroll
        for (int r = 0; r < 16; ++r) { const int orow = crow(r, hi); const float ra = wsf[orow];
            float rb = 0.f; if (MODE == 1) rb = wsf[32 + orow] * lam;
#pragma unroll
            for (int d0 = 0; d0 < 2; ++d0) { float v = o[d0][r] * ra; if (MODE == 1) v -= o2[d0][r] * rb;
                stg[orow * 64 + d0 * 32 + r32] = (bf16)(pk2(v, 0.f) & 0xffffu); } }
        asm volatile("s_waitcnt lgkmcnt(0)" ::: "memory");
#pragma unroll
        for (int i = 0; i < 4; ++i) { const int row = i * 8 + (lane >> 3), ch = lane & 7;
            u32x4 v = *(const LAS u32x4*)(stg + row * 64 + ch * 8);
            if (MODE == 1) {
                float x[8] = {bflo(v.x), bfhi(v.x), bflo(v.y), bfhi(v.y), bflo(v.z), bfhi(v.z), bflo(v.w), bfhi(v.w)};
                float ss = 0.f;
#pragma unroll
                for (int j = 0; j < 8; ++j) ss += x[j] * x[j];
                ss += __shfl_xor(ss, 1); ss += __shfl_xor(ss, 2); ss += __shfl_xor(ss, 4);
                const float rs = rsqrtf(ss * (1.0f / 64.0f) + LN_EPS) * (1.0f - ax.lam_init);
                const f32x4 ga = *(const f32x4*)(ax.subln + ch * 8), gb = *(const f32x4*)(ax.subln + ch * 8 + 4);
                v.x = pk2(x[0] * rs * ga[0], x[1] * rs * ga[1]); v.y = pk2(x[2] * rs * ga[2], x[3] * rs * ga[3]);
                v.z = pk2(x[4] * rs * gb[0], x[5] * rs * gb[1]); v.w = pk2(x[6] * rs * gb[2], x[7] * rs * gb[3]);
            }
            *(u32x4*)(Ow + (long)row * PITCH + ch * 8) = v; }
    }
    asm volatile("s_waitcnt lgkmcnt(0)\n\ts_barrier" ::: "memory");
#undef DMA_K
#undef DMA_V
}
}

template <int CTRL> __device__ __forceinline__ int dppi(int v) { return __builtin_amdgcn_update_dpp(0, v, CTRL, 0xf, 0xf, false); }
__device__ __forceinline__ int wave_sum_i(int v) {
    v += dppi<0xB1>(v); v += dppi<0x4E>(v); v += dppi<0x141>(v); v += dppi<0x140>(v);
    return __builtin_amdgcn_readlane(v, 0) + __builtin_amdgcn_readlane(v, 16) + __builtin_amdgcn_readlane(v, 32) + __builtin_amdgcn_readlane(v, 48);
}
namespace pre {
__device__ __forceinline__ void cumsum_task(int task, const float* logf, float* c2) {
    int tid_ = threadIdx.x; asm volatile("" : "+v"(tid_));
    const int lane = tid_ & 63, wid = tid_ >> 6;
    const int seq = task * 8 + wid, b = seq >> 2, h = seq & 3;
    const float* src = logf + ((size_t)b * SEQ + lane * 32) * 4 + h;
    float tot = 0.f;
    for (int i = 0; i < 32; ++i) tot += src[i * 4];
    float incl = tot;
#pragma unroll
    for (int off = 1; off < 64; off <<= 1) { const float n = __shfl_up(incl, off); if (lane >= off) incl += n; }
    float run = incl - tot;
    float* dst = c2 + ((size_t)b * 4 + h) * SEQ + lane * 32;
    for (int i = 0; i < 32; ++i) { run += src[i * 4]; dst[i] = run * LOG2E; }
}
__device__ __forceinline__ void kmean_task(int task, const bf16* K, bf16* kmean) {
    int tid_ = threadIdx.x; asm volatile("" : "+v"(tid_));
    const int lane = tid_ & 63, wid = tid_ >> 6;
    const int idx = task * 8 + wid, b = idx >> 5, h = (idx >> 3) & 3, n = idx & 7;
    const bf16* src = K + (((size_t)b * 4 + h) * 32 + n * 4) * 4096 + lane * 8;
    float s[8][8];
#pragma unroll
    for (int c = 0; c < 8; ++c)
#pragma unroll
        for (int d = 0; d < 8; ++d) s[c][d] = 0.f;
#pragma unroll
    for (int t = 0; t < 4; ++t)
#pragma unroll
        for (int c = 0; c < 8; ++c) { const u32x4 v = *(const u32x4*)(src + (size_t)t * 4096 + c * 512);
            s[c][0] += bflo(v.x); s[c][1] += bfhi(v.x); s[c][2] += bflo(v.y); s[c][3] += bfhi(v.y); s[c][4] += bflo(v.z); s[c][5] += bfhi(v.z); s[c][6] += bflo(v.w); s[c][7] += bfhi(v.w); }
    float mine = 0.f;
#pragma unroll
    for (int c = 0; c < 8; ++c)
#pragma unroll
        for (int d = 0; d < 8; ++d) { const float tsum = wave_sum(s[c][d]); if (lane == 8 * c + d) mine = tsum; }
    kmean[(size_t)idx * 64 + lane] = (bf16)(pk2(mine * (1.0f / 256.0f), 0.f) & 0xffffu);
}
__device__ __forceinline__ unsigned mono(float v) { const unsigned u = __float_as_uint(v); return (u & 0x80000000u) ? ~u : (u | 0x80000000u); }
__device__ __forceinline__ void d1_unit(int b, int j, const bf16* IQ, const bf16* IK, const float* IW, float* S, unsigned long long* MASK, LAS unsigned char* lds, int bmask = 7) {
    int tid_ = threadIdx.x; asm volatile("" : "+v"(tid_));
    const int tid = tid_, lane = tid & 63, r32 = lane & 31, hi = lane >> 5; const int wid = __builtin_amdgcn_readfirstlane(tid >> 6);
    const int q0 = 32 * j; const long rowbase = (long)b * SEQ;
    const int nt = (q0 + 32 + 63) >> 6;
    const bool need_sel = (q0 >= 256);
    if (need_sel && (bmask & 1)) {
        {   const u32x4 qv = *(const u32x4*)(IQ + (size_t)(rowbase + q0 + (tid >> 5)) * 256 + (tid & 31) * 8);
            *(LAS u32x4*)(lds + 98304 + (tid >> 5) * 528 + (tid & 31) * 16) = qv;
            const u32x4 qv2 = *(const u32x4*)(IQ + (size_t)(rowbase + q0 + 16 + (tid >> 5)) * 256 + (tid & 31) * 8);
            *(LAS u32x4*)(lds + 98304 + (16 + (tid >> 5)) * 528 + (tid & 31) * 16) = qv2; }
        const f32x4 w4 = *(const f32x4*)(IW + (size_t)(rowbase + q0 + r32) * 4);
        LDS_WAIT(); __syncthreads();
        const LAS unsigned char* qil = lds + 98304 + r32 * 528 + hi * 16;
        bf16x8 kn0[4], kn1[4];
        if (wid < nt) {
#pragma unroll
            for (int d0 = 0; d0 < 4; ++d0) { kn0[d0] = *(const bf16x8*)(IK + (size_t)(rowbase + 64 * wid + r32) * 64 + d0 * 16 + hi * 8);
                                             kn1[d0] = *(const bf16x8*)(IK + (size_t)(rowbase + 64 * wid + 32 + r32) * 64 + d0 * 16 + hi * 8); } }
        for (int t = wid; t < nt; t += 8) {
            const int kv0 = 64 * t;
            bf16x8 k0[4], k1[4];
#pragma unroll
            for (int d0 = 0; d0 < 4; ++d0) { k0[d0] = kn0[d0]; k1[d0] = kn1[d0]; }
            if (t + 8 < nt) {
#pragma unroll
                for (int d0 = 0; d0 < 4; ++d0) { kn0[d0] = *(const bf16x8*)(IK + (size_t)(rowbase + kv0 + 512 + r32) * 64 + d0 * 16 + hi * 8);
                                                 kn1[d0] = *(const bf16x8*)(IK + (size_t)(rowbase + kv0 + 544 + r32) * 64 + d0 * 16 + hi * 8); } }
            f32x16 s0 = {}, s1 = {};
#pragma unroll 1
            for (int hh = 0; hh < 4; ++hh) {
                bf16x8 qi[4];
#pragma unroll
                for (int d0 = 0; d0 < 4; ++d0) qi[d0] = *(const LAS bf16x8*)(qil + hh * 128 + d0 * 32);
                const float wh = hh == 0 ? w4[0] : hh == 1 ? w4[1] : hh == 2 ? w4[2] : w4[3];
                f32x16 p0 = {}, p1 = {};
#pragma unroll
                for (int d0 = 0; d0 < 4; ++d0) { p0 = __builtin_amdgcn_mfma_f32_32x32x16_bf16(k0[d0], qi[d0], p0, 0, 0, 0); p1 = __builtin_amdgcn_mfma_f32_32x32x16_bf16(k1[d0], qi[d0], p1, 0, 0, 0); }
#pragma unroll
                for (int r = 0; r < 16; ++r) { s0[r] = __builtin_fmaf(wh, __builtin_amdgcn_fmed3f(p0[r], 0.f, 3.0e38f), s0[r]); s1[r] = __builtin_fmaf(wh, __builtin_amdgcn_fmed3f(p1[r], 0.f, 3.0e38f), s1[r]); }
            }
            {   LAS float* stg = (LAS float*)(lds + wid * 8704);
                LAS float* wp = stg + r32 * 68 + 4 * hi;
#pragma unroll
                for (int jj = 0; jj < 4; ++jj) { *(LAS f32x4*)(wp + 8 * jj) = (f32x4){s0[4 * jj], s0[4 * jj + 1], s0[4 * jj + 2], s0[4 * jj + 3]};
                                                 *(LAS f32x4*)(wp + 32 + 8 * jj) = (f32x4){s1[4 * jj], s1[4 * jj + 1], s1[4 * jj + 2], s1[4 * jj + 3]}; }
                LDS_WAIT(); asm volatile("" ::: "memory");
                float* gp = S + (size_t)(rowbase + q0 + (lane >> 4)) * SEQ + kv0 + 4 * (lane & 15);
#pragma unroll
                for (int rr = 0; rr < 8; ++rr) *(f32x4*)(gp + (size_t)(4 * rr) * SEQ) = *(const LAS f32x4*)(stg + (4 * rr + (lane >> 4)) * 68 + 4 * (lane & 15));
                LDS_WAIT(); asm volatile("" ::: "memory"); }
        }
    }
    VM_WAIT(); __syncthreads();
    f32x4 svn[8];
    if (need_sel && (bmask & 2)) {
#pragma unroll
        for (int g = 0; g < 8; ++g) svn[g] = *(const f32x4*)(S + (size_t)(rowbase + q0 + 4 * wid) * SEQ + 256 * g + 4 * lane); }
    for (int i = 0; i < 4; ++i) {
        const int q = q0 + 4 * wid + i;
        const float* srow = S + (size_t)(rowbase + q) * SEQ;
        unsigned tkey = 0u, tik = 0u;
        unsigned key[32];
#define D1_KIDX(x) (256 * ((x) >> 2) + 4 * lane + ((x) & 3))
        if (need_sel && (bmask & 2)) {
            {
#pragma unroll
                for (int x = 0; x < 32; ++x) key[x] = (D1_KIDX(x) <= q) ? mono(svn[x >> 2][x & 3]) : 0u;
                if (i < 3) {
#pragma unroll
                    for (int g = 0; g < 8; ++g) svn[g] = *(const f32x4*)(srow + SEQ + 256 * g + 4 * lane); } }
            const int ng = (q >> 8) + 1;
#define D1_COUNT(dst, COND) do { int c_ = 0; \
                _Pragma("unroll") for (int g_ = 0; g_ < 8; ++g_) if (g_ < ng) { _Pragma("unroll") for (int cc_ = 0; cc_ < 4; ++cc_) { const int ch = g_ * 4 + cc_; c_ += (COND) ? 1 : 0; } } \
                dst = wave_sum_i(c_); } while (0)
            unsigned T = 0u; bool exact = false;
            for (int bit = 31; bit >= 0; --bit) {
                const unsigned cand = T | (1u << bit);
                int cnt; D1_COUNT(cnt, key[ch] >= cand);
                if (cnt >= 256) { T = cand; if (cnt == 256) { exact = true; break; } }
            }
            tkey = T;
            if (!exact) {
                int cg, ce; D1_COUNT(cg, key[ch] > T); D1_COUNT(ce, key[ch] == T);
                const int r = 256 - cg;
                if (ce != r) { unsigned I = 0u;
                    for (int bit = 10; bit >= 0; --bit) { const unsigned cand = I | (1u << bit); int cnt;
                        D1_COUNT(cnt, key[ch] == T && (2047u - (unsigned)D1_KIDX(ch)) >= cand);
                        if (cnt >= r) I = cand; }
                    tik = I; }
            }
#undef D1_COUNT
        } else {
#pragma unroll
            for (int x = 0; x < 32; ++x) key[x] = (D1_KIDX(x) <= q) ? 1u : 0u;
        }
        const int nchunk = (bmask & 4) ? 4 * (j >> 3) + 4 : 0;
        unsigned mlo = 0u, mhi = 0u;
#pragma unroll
        for (int g = 0; g < 8; ++g) {
            unsigned nib = 0u;
#pragma unroll
            for (int e = 0; e < 4; ++e) { const unsigned kk = key[4 * g + e], ik = 2047u - (unsigned)D1_KIDX(4 * g + e);
                nib |= ((kk != 0u) && ((kk > tkey) || (kk == tkey && ik >= tik))) ? (1u << e) : 0u; }
            const int sh = 4 * (lane & 15);
            int lo = (sh < 32) ? (int)(nib << sh) : 0, hi = (sh >= 32) ? (int)(nib << (sh - 32)) : 0;
            lo |= dppi<0xB1>(lo); hi |= dppi<0xB1>(hi); lo |= dppi<0x4E>(lo); hi |= dppi<0x4E>(hi);
            lo |= dppi<0x141>(lo); hi |= dppi<0x141>(hi); lo |= dppi<0x140>(lo); hi |= dppi<0x140>(hi);
            if ((lane & 15) == g) { mlo = (unsigned)lo; mhi = (unsigned)hi; }
        }
#undef D1_KIDX
        { const int chunk = 4 * (lane & 15) + (lane >> 4);
          if ((lane & 15) < 8 && chunk < nchunk) MASK[(size_t)(rowbase + q) * 32 + chunk] = ((unsigned long long)mhi << 32) | mlo; }
    }
    __syncthreads();
}
}

namespace rw {
__device__ __forceinline__ void ln_store(f32x4 (&v)[4], const float* g, const float* bb, float* of, bf16* ob, int lane) {
    float s = 0.f;
#pragma unroll
    for (int j = 0; j < 4; ++j) s += (v[j][0] + v[j][1]) + (v[j][2] + v[j][3]);
    const float mean = wave_sum(s) * (1.0f / DM); float s2 = 0.f;
#pragma unroll
    for (int j = 0; j < 4; ++j) { v[j] = v[j] - mean; s2 += (v[j][0] * v[j][0] + v[j][1] * v[j][1]) + (v[j][2] * v[j][2] + v[j][3] * v[j][3]); }
    const float rstd = rsqrtf(wave_sum(s2) * (1.0f / DM) + LN_EPS);
#pragma unroll
    for (int j = 0; j < 4; ++j) {
        const f32x4 gg = *(const f32x4*)(g + 4 * lane + 256 * j), b4 = *(const f32x4*)(bb + 4 * lane + 256 * j);
        const f32x4 o = v[j] * rstd * gg + b4;
        *(f32x4*)(of + 4 * lane + 256 * j) = o;
        u32x2 w; w.x = pk2(o[0], o[1]); w.y = pk2(o[2], o[3]);
        *(u32x2*)(ob + 4 * lane + 256 * j) = w;
    }
}
template <int R, bool MAP8 = false, bool F8OUT = false>
__device__ __forceinline__ void ln_store_n(f32x4 (&v)[R][4], const float* g, const float* bb, float* const (&of)[R], bf16* const (&ob)[R], int lane, long lo_off = 0, unsigned char* f8 = nullptr, const bf16* ob0 = nullptr) {
    float s[R], s2[R]; int f8lo[R];
#pragma unroll
    for (int r = 0; r < R; ++r) { s[r] = 0.f;
#pragma unroll
        for (int j = 0; j < 4; ++j) s[r] += (v[r][j][0] + v[r][j][1]) + (v[r][j][2] + v[r][j][3]); }
#pragma unroll
    for (int o = 1; o < 64; o <<= 1)
#pragma unroll
        for (int r = 0; r < R; ++r) s[r] += __shfl_xor(s[r], o);
#pragma unroll
    for (int r = 0; r < R; ++r) { const float mean = s[r] * (1.0f / DM); s2[r] = 0.f;
#pragma unroll
        for (int j = 0; j < 4; ++j) { v[r][j] = v[r][j] - mean; s2[r] += (v[r][j][0] * v[r][j][0] + v[r][j][1] * v[r][j][1]) + (v[r][j][2] * v[r][j][2] + v[r][j][3] * v[r][j][3]); } }
#pragma unroll
    for (int o = 1; o < 64; o <<= 1)
#pragma unroll
        for (int r = 0; r < R; ++r) s2[r] += __shfl_xor(s2[r], o);
#pragma unroll
    for (int j = 0; j < 4; ++j) {
        const int col = MAP8 ? (512 * (j >> 1) + 8 * lane + 4 * (j & 1)) : (4 * lane + 256 * j);
        const f32x4 gg = *(const f32x4*)(g + col), b4 = *(const f32x4*)(bb + col);
#pragma unroll
        for (int r = 0; r < R; ++r) {
            const float rstd = rsqrtf(s2[r] * (1.0f / DM) + LN_EPS);
            const f32x4 o = v[r][j] * rstd * gg + b4;
            if (of[r]) *(f32x4*)(of[r] + col) = o;
            u32x2 w; w.x = pk2(o[0], o[1]); w.y = pk2(o[2], o[3]);
            *(u32x2*)(ob[r] + col) = w;
            if (lo_off) { u32x2 wl; wl.x = pk2(o[0] - bflo(w.x), o[1] - bfhi(w.x)); wl.y = pk2(o[2] - bflo(w.y), o[3] - bfhi(w.y)); *(u32x2*)(ob[r] + lo_off + col) = wl; }
            if constexpr (F8OUT && MAP8) {
                int t = 0; t = __builtin_amdgcn_cvt_pk_fp8_f32(o[0], o[1], t, false); t = __builtin_amdgcn_cvt_pk_fp8_f32(o[2], o[3], t, true);
                if ((j & 1) == 0) f8lo[r] = t; else *(u32x2*)(f8 + (ob[r] - ob0) + 512 * (j >> 1) + 8 * lane) = (u32x2){(unsigned)f8lo[r], (unsigned)t}; } }
    }
}
__device__ __forceinline__ void route_row(const float* sc, const float* bias, int lane, int (&e)[8], float (&w)[8]) {
    const f32x4 s4 = *(const f32x4*)(sc + 4 * lane), b4 = *(const f32x4*)(bias + 4 * lane);
    float bv[4] = {s4[0] + b4[0], s4[1] + b4[1], s4[2] + b4[2], s4[3] + b4[3]};
    float a = fmaxf(bv[0], bv[1]), b = fminf(bv[0], bv[1]), c = fmaxf(bv[2], bv[3]), d = fminf(bv[2], bv[3]);
    float m1 = fmaxf(a, c), m2 = fmaxf(fminf(a, c), fmaxf(b, d));
#pragma unroll
    for (int off = 1; off < 8; off <<= 1) { const float o1 = __shfl_xor(m1, off), o2 = __shfl_xor(m2, off); const float n1 = fmaxf(m1, o1), n2 = fmaxf(fminf(m1, o1), fmaxf(m2, o2)); m1 = n1; m2 = n2; }
    const float gs = m1 + m2; const int grp = lane >> 3;
    int rank = 0;
#pragma unroll
    for (int jg = 0; jg < 8; ++jg) { const float o = __shfl(gs, jg * 8); rank += (o > gs || (o == gs && jg < grp)) ? 1 : 0; }
    const bool sel = rank < 4;
    float mv[4];
#pragma unroll
    for (int i = 0; i < 4; ++i) mv[i] = sel ? bv[i] : -INFINITY;
    float wsum = 0.f;
#pragma unroll
    for (int r = 0; r < 8; ++r) {
        float best = mv[0]; int bi = 0;
#pragma unroll
        for (int i = 1; i < 4; ++i) if (mv[i] > best) { best = mv[i]; bi = i; }
        int idx = 4 * lane + bi;
#pragma unroll
        for (int off = 32; off >= 1; off >>= 1) { const float ov = __shfl_xor(best, off); const int oi = __shfl_xor(idx, off); if (ov > best || (ov == best && oi < idx)) { best = ov; idx = oi; } }
        const int ow = idx >> 2, oi4 = idx & 3;
        const float sv = oi4 == 0 ? s4[0] : oi4 == 1 ? s4[1] : oi4 == 2 ? s4[2] : s4[3];
        w[r] = __shfl(sv, ow); e[r] = idx; wsum += w[r];
        if (lane == ow) {
#pragma unroll
            for (int i = 0; i < 4; ++i) if (i == oi4) mv[i] = -INFINITY; }
    }
    const float sc8 = 2.5f / wsum;
#pragma unroll
    for (int r = 0; r < 8; ++r) w[r] *= sc8;
}
template <int CTRL> __device__ __forceinline__ float dppf(float v) { return __builtin_bit_cast(float, __builtin_amdgcn_update_dpp(0, __builtin_bit_cast(int, v), CTRL, 0xf, 0xf, false)); }
__device__ __forceinline__ float wave_max(float v) {
    v = fmaxf(v, dppf<0xB1>(v)); v = fmaxf(v, dppf<0x4E>(v)); v = fmaxf(v, dppf<0x141>(v)); v = fmaxf(v, dppf<0x140>(v));
    const float a = __builtin_bit_cast(float, __builtin_amdgcn_readlane(__builtin_bit_cast(int, v), 0)), b = __builtin_bit_cast(float, __builtin_amdgcn_readlane(__builtin_bit_cast(int, v), 16));
    const float c = __builtin_bit_cast(float, __builtin_amdgcn_readlane(__builtin_bit_cast(int, v), 32)), d = __builtin_bit_cast(float, __builtin_amdgcn_readlane(__builtin_bit_cast(int, v), 48));
    return fmaxf(fmaxf(a, b), fmaxf(c, d));
}
template <int R>
__device__ __forceinline__ void route_rows(const float* sc, const float* bias, int lane, int (&e)[R][8], float (&w)[R][8]) {
    const f32x4 b4 = *(const f32x4*)(bias + 4 * lane);
    f32x4 s4[R]; float bv[R][4], m1[R], m2[R], mv[R][4], wsum[R];
#pragma unroll
    for (int r = 0; r < R; ++r) { s4[r] = *(const f32x4*)(sc + (size_t)r * 256 + 4 * lane);
#pragma unroll
        for (int i = 0; i < 4; ++i) bv[r][i] = s4[r][i] + b4[i];
        const float a = fmaxf(bv[r][0], bv[r][1]), b = fminf(bv[r][0], bv[r][1]), c = fmaxf(bv[r][2], bv[r][3]), d = fminf(bv[r][2], bv[r][3]);
        m1[r] = fmaxf(a, c); m2[r] = fmaxf(fminf(a, c), fmaxf(b, d)); }
#pragma unroll
    for (int r = 0; r < R; ++r) {
        { const float o1 = dppf<0xB1>(m1[r]), o2 = dppf<0xB1>(m2[r]); const float n1 = fmaxf(m1[r], o1), n2 = fmaxf(fminf(m1[r], o1), fmaxf(m2[r], o2)); m1[r] = n1; m2[r] = n2; }
        { const float o1 = dppf<0x4E>(m1[r]), o2 = dppf<0x4E>(m2[r]); const float n1 = fmaxf(m1[r], o1), n2 = fmaxf(fminf(m1[r], o1), fmaxf(m2[r], o2)); m1[r] = n1; m2[r] = n2; }
        { const float o1 = dppf<0x141>(m1[r]), o2 = dppf<0x141>(m2[r]); const float n1 = fmaxf(m1[r], o1), n2 = fmaxf(fminf(m1[r], o1), fmaxf(m2[r], o2)); m1[r] = n1; m2[r] = n2; }
    }
    const int grp = lane >> 3;
#pragma unroll
    for (int r = 0; r < R; ++r) { const float gs = m1[r] + m2[r]; int rank = 0; wsum[r] = 0.f;
#pragma unroll
        for (int jg = 0; jg < 8; ++jg) { const float o = __builtin_bit_cast(float, __builtin_amdgcn_readlane(__builtin_bit_cast(int, gs), jg * 8)); rank += (o > gs || (o == gs && jg < grp)) ? 1 : 0; }
#pragma unroll
        for (int i = 0; i < 4; ++i) mv[r][i] = (rank < 4) ? bv[r][i] : -INFINITY; }
#pragma unroll
    for (int rd = 0; rd < 8; ++rd) {
#pragma unroll
        for (int r = 0; r < R; ++r) {
            const float M = wave_max(fmaxf(fmaxf(mv[r][0], mv[r][1]), fmaxf(mv[r][2], mv[r][3])));
            const int bi = (mv[r][0] == M) ? 0 : (mv[r][1] == M) ? 1 : (mv[r][2] == M) ? 2 : (mv[r][3] == M) ? 3 : 4;
            const unsigned long long bal = __ballot(bi < 4);
            const int ow = __builtin_amdgcn_readfirstlane((int)__ffsll((unsigned long long)bal) - 1);
            const float sv = bi == 0 ? s4[r][0] : bi == 1 ? s4[r][1] : bi == 2 ? s4[r][2] : s4[r][3];
            const int oi4 = __builtin_amdgcn_readlane(bi, ow);
            w[r][rd] = __builtin_bit_cast(float, __builtin_amdgcn_readlane(__builtin_bit_cast(int, sv), ow)); e[r][rd] = 4 * ow + oi4; wsum[r] += w[r][rd];
            if (lane == ow) {
#pragma unroll
                for (int i = 0; i < 4; ++i) if (i == oi4) mv[r][i] = -INFINITY; }
        }
    }
#pragma unroll
    for (int r = 0; r < R; ++r) { const float sc8 = 2.5f / wsum[r];
#pragma unroll
        for (int k = 0; k < 8; ++k) w[r][k] *= sc8; }
}
__device__ __forceinline__ void expert_tables(const unsigned* cnt  , LAS int* tp, LAS int* st) {
    __syncthreads();
    int tid_ = threadIdx.x; asm volatile("" : "+v"(tid_));
    if (tid_ < 64) {
        const int lane = tid_;
        int c[4], tl[4]; int cs = 0, ts = 0;
#pragma unroll
        for (int i = 0; i < 4; ++i) { c[i] = (int)__hip_atomic_load(cnt + 64 * (4 * lane + i), RLX_AGENT); tl[i] = (c[i] + 255) >> 8; cs += c[i]; ts += tl[i]; }
        int ci = cs, ti = ts;
#pragma unroll
        for (int off = 1; off < 64; off <<= 1) { const int n1 = __shfl_up(ci, off), n2 = __shfl_up(ti, off); if (lane >= off) { ci += n1; ti += n2; } }
        int ce = ci - cs, te = ti - ts;
#pragma unroll
        for (int i = 0; i < 4; ++i) { st[4 * lane + i] = ce; tp[4 * lane + i] = te; ce += c[i]; te += tl[i]; }
        if (lane == 63) { st[256] = ce; tp[256] = te; st[257] = ce + NTOK; tp[257] = te + NTOK / 256; }
    }
    __syncthreads();
}
}

namespace pro {
__device__ __forceinline__ int in_src_col(int p) {
    const int tile = p >> 8, c = p & 255;
    if (tile < 12) { const int br = tile / 3, kind = tile % 3;
        const int segbase = (br == 0 ? 0 : br == 1 ? 768 : br == 2 ? 1536 : 2308) + kind * 256;
        int orig = c;
        if (kind < 2) { if (br == 0 || br == 3) { const int pp = c & 63; orig = (c & ~63) + (pp >> 1) + 32 * (pp & 1); }
                        else if (br == 1) { const int pp = c & 31; orig = (c & ~31) + (pp >> 1) + 16 * (pp & 1); } }
        return segbase + orig; }
    if (tile == 12) { const int pp = c & 63; return 3076 + (c & ~63) + (pp >> 1) + 32 * (pp & 1); }
    if (tile == 13) { if (c < 64) return 3332 + (c >> 1) + 32 * (c & 1); if (c < 68) return 2304 + (c - 64); if (c < 72) return 3396 + (c - 68); return -1; }
    return 3400 + (tile - 14) * 256 + c;
}
template <class F>
__device__ __forceinline__ void transpose_item(const float* W, int ldw, int K, bf16* WT, int rs, int ro, LAS float* scr, int kb, int nb, int lane, F srcc) {
    const int k0 = 64 * kb, n0 = 32 * nb;
    const int sc = srcc(n0 + (lane & 31));
#pragma unroll 8
    for (int i = 0; i < 32; ++i) { const int kk = 2 * i + (lane >> 5); scr[kk * 33 + (lane & 31)] = (sc >= 0) ? W[(size_t)(k0 + kk) * ldw + sc] : 0.f; }
    LDS_WAIT(); asm volatile("" ::: "memory");
    const int c = lane & 7;
#pragma unroll
    for (int j = 0; j < 4; ++j) { const int n = (lane >> 3) + 8 * j; const LAS float* s = scr + (8 * c) * 33 + n;
        u32x4 o; o.x = pk2(s[0 * 33], s[1 * 33]); o.y = pk2(s[2 * 33], s[3 * 33]); o.z = pk2(s[4 * 33], s[5 * 33]); o.w = pk2(s[6 * 33], s[7 * 33]);
        *(u32x4*)(WT + (size_t)((n0 + n) * rs + ro) * K + k0 + 8 * c) = o; }
    LDS_WAIT(); asm volatile("" ::: "memory");
}
__device__ __forceinline__ unsigned pk2lo(float a, float b) { const unsigned h = pk2(a, b); return pk2(a - bflo(h), b - bfhi(h)); }
__device__ __forceinline__ void transpose_load_v4(f32x4 (&v)[8], const float* W, int ldw, int kb, int nb, int lane) {
    const float* src = W + (size_t)(64 * kb + (lane >> 3)) * ldw + 32 * nb + (lane & 7) * 4;
#pragma unroll
    for (int i = 0; i < 8; ++i) v[i] = *(const f32x4*)(src + (size_t)(8 * i) * ldw);
}
template <bool LO = false>
__device__ __forceinline__ void transpose_finish_v4(const f32x4 (&v)[8], int K, bf16* WT, int rs, int ro, LAS float* scr, int kb, int nb, int lane) {
    const int k0 = 64 * kb, n0 = 32 * nb;
#pragma unroll
    for (int i = 0; i < 8; ++i) *(LAS f32x4*)(scr + (8 * i + (lane >> 3)) * 36 + (lane & 7) * 4) = v[i];
    LDS_WAIT(); asm volatile("" ::: "memory");
    const int c = lane & 7;
#pragma unroll
    for (int j = 0; j < 4; ++j) { const int n = (lane >> 3) + 8 * j; const LAS float* s = scr + (8 * c) * 36 + n;
        u32x4 o;
        if (LO) { o.x = pk2lo(s[0 * 36], s[1 * 36]); o.y = pk2lo(s[2 * 36], s[3 * 36]); o.z = pk2lo(s[4 * 36], s[5 * 36]); o.w = pk2lo(s[6 * 36], s[7 * 36]); }
        else { o.x = pk2(s[0 * 36], s[1 * 36]); o.y = pk2(s[2 * 36], s[3 * 36]); o.z = pk2(s[4 * 36], s[5 * 36]); o.w = pk2(s[6 * 36], s[7 * 36]); }
        *(u32x4*)(WT + (size_t)((n0 + n) * rs + ro) * K + k0 + 8 * c) = o; }
    LDS_WAIT(); asm volatile("" ::: "memory");
}
__device__ __forceinline__ void transpose_finish_f8(const f32x4 (&v)[8], int K, unsigned char* WT, float scl, LAS float* scr, int kb, int nb, int lane, int rs = 1, int ro = 0) {
    const int k0 = 64 * kb, n0 = 32 * nb;
#pragma unroll
    for (int i = 0; i < 8; ++i) *(LAS f32x4*)(scr + (8 * i + (lane >> 3)) * 36 + (lane & 7) * 4) = v[i];
    LDS_WAIT(); asm volatile("" ::: "memory");
    const int c = lane & 3;
#pragma unroll
    for (int j = 0; j < 2; ++j) { const int n = (lane >> 2) + 16 * j; const LAS float* s = scr + (16 * c) * 36 + n;
        int w[4];
#pragma unroll
        for (int q = 0; q < 4; ++q) { int t = 0; t = __builtin_amdgcn_cvt_pk_fp8_f32(s[(4 * q + 0) * 36] * scl, s[(4 * q + 1) * 36] * scl, t, false);
            t = __builtin_amdgcn_cvt_pk_fp8_f32(s[(4 * q + 2) * 36] * scl, s[(4 * q + 3) * 36] * scl, t, true); w[q] = t; }
        *(u32x4*)(WT + ((size_t)(n0 + n) * rs + ro) * K + k0 + 16 * c) = (u32x4){(unsigned)w[0], (unsigned)w[1], (unsigned)w[2], (unsigned)w[3]}; }
    LDS_WAIT(); asm volatile("" ::: "memory");
}
template <bool LO = false>
__device__ __forceinline__ void transpose_item_v4(const float* W, int ldw, int K, bf16* WT, int rs, int ro, LAS float* scr, int kb, int nb, int lane) {
    f32x4 v[8]; transpose_load_v4(v, W, ldw, kb, nb, lane); transpose_finish_v4<LO>(v, K, WT, rs, ro, scr, kb, nb, lane);
}
struct IdCol { __device__ __forceinline__ int operator()(int n) const { return n; } };
struct InCol { __device__ __forceinline__ int operator()(int n) const { return in_src_col(n); } };
}

constexpr int NPHASE = 17;
#ifndef PHM
#define PHM 0x1ff
#endif
#define PH_EN(k) (((PHM) >> (k)) & 1)
#ifndef REP_P0
#define REP_P0 1
#endif
#ifndef REP_A
#define REP_A 1
#endif
#ifndef REP_B
#define REP_B 1
#endif
#ifndef REP_C
#define REP_C 1
#endif
#ifndef REP_D
#define REP_D 1
#endif
#ifndef REP_F
#define REP_F 1
#endif
#ifndef REP_E
#define REP_E 1
#endif
#ifndef REP_H
#define REP_H 1
#endif
#ifndef REP_G
#define REP_G 1
#endif
#define REPEAT(n) _Pragma("unroll 1") for (int rep = 0; rep < (n); ++rep)
#define REP_SYNC do { if (rep) xcd_barrier(bar); } while (0)
#ifndef ROUTER_HILO
#define ROUTER_HILO 0
#endif
#ifndef GNULL
#define GNULL 0
#endif
#ifndef BMASK
#define BMASK 7
#endif
#ifndef EMASK
#define EMASK 15
#endif
struct Args { const float* in[19]; float* out; unsigned char* ws; int ph_lo, ph_hi; };
__global__ void __launch_bounds__(NTHREADS, 2) mk_fwd(Args args) {
    extern __shared__ __attribute__((aligned(16))) unsigned char lds_raw[];
    LAS unsigned char* lds = (LAS unsigned char*)lds_raw;
    volatile LAS unsigned* MISC = (volatile LAS unsigned*)(lds + LX_MISC);
    LAS int* TP = (LAS int*)(lds + LX_TP); LAS int* ST = (LAS int*)(lds + LX_ST);
    unsigned char* ws = args.ws;
    unsigned* ctl = (unsigned*)(ws + WS_CTL);
    for (int u = threadIdx.x; u < (LDS_BYTES - LX_BASE) / 4; u += NTHREADS) ((LAS unsigned*)(lds + LX_BASE))[u] = 0u;
    __syncthreads();
    XcdBarrier bar; bar.bar = ctl + CW_BAR; bar.x = 0; bar.st = MISC + 8;
#if MK_ONE_LAUNCH
    bar = xcd_barrier_post(ctl + CW_BAR, MISC + 8);
#endif
    const int lo = args.ph_lo, hi = args.ph_hi;
#define IN(k) (lo <= (k) && (k) < hi)
#define SEAM(k) do { if (IN(k) && IN((k) + 1)) xcd_barrier(bar); } while (0)
#define QNEXT(ctr, dst) do { __syncthreads(); int t0_ = threadIdx.x; asm volatile("" : "+v"(t0_)); if (t0_ == 0) MISC[0] = __hip_atomic_fetch_add((ctr), 1u, RLX_AGENT); __syncthreads(); dst = (int)MISC[0]; } while (0)
#define KARGS const __attribute__((address_space(4))) Args* ka = (const __attribute__((address_space(4))) Args*)__builtin_amdgcn_kernarg_segment_ptr(); asm volatile("" : "+s"(ka))
#define QPREF(ctr) int qn_ = 0; { int t0_ = threadIdx.x; asm volatile("" : "+v"(t0_)); if (t0_ == 0) qn_ = (int)__hip_atomic_fetch_add((ctr), 1u, RLX_AGENT); }
#define QTAKE(dst) do { __syncthreads(); int t0_ = threadIdx.x; asm volatile("" : "+v"(t0_)); if (t0_ == 0) MISC[0] = (unsigned)qn_; __syncthreads(); dst = (int)MISC[0]; } while (0)
#define OPAQUE_CG int c = blockIdx.x, G = gridDim.x; asm volatile("" : "+s"(c), "+s"(G))
#define OPAQUE_IDS int tid = threadIdx.x; asm volatile("" : "+v"(tid)); const int lane = tid & 63, wid = __builtin_amdgcn_readfirstlane(tid >> 6); (void)lane; (void)wid
    bf16* const XB = (bf16*)(ws + A_X1B);

    if (PH_EN(8) && IN(0)) REPEAT(REP_P0) {
        REP_SYNC;
        OPAQUE_IDS; KARGS; OPAQUE_CG;
        LAS float* scr = (LAS float*)(lds + wid * 16384);
        const int gw = c * NWAVES + wid, NGW = G * NWAVES;
        constexpr int I_IN = 16 * 112, I_G8 = 16 * 128, I_BR = 4 * 128, I_WO = 512, I_WR = 128, I_L = I_IN + I_G8 + I_BR + I_WO + 2 * I_WR;
        for (int it = gw; it < 2 * I_L; it += NGW) {
            const int l = it / I_L; int r = it % I_L;
            unsigned char* dw = ws + WS_DENSE + (size_t)l * DENSE_L;
            if (r < I_IN) { pro::transpose_item(ka->in[1] + (size_t)l * 1024 * IN_SRC, IN_SRC, 1024, (bf16*)(dw + DW_WIN), 1, 0, scr, r / 112, r % 112, lane, pro::InCol()); continue; } r -= I_IN;
            if (r < I_G8) { f32x4 v8[8]; pro::transpose_load_v4(v8, ka->in[1] + (size_t)l * 1024 * IN_SRC + 3400, IN_SRC, r / 128, r % 128, lane);
                pro::transpose_finish_f8(v8, 1024, dw + DW_WG8, -32.0f * LOG2E, scr, r / 128, r % 128, lane); continue; } r -= I_G8;
            if (r < I_BR) { const int bi = r / 128, rr = r % 128;
                pro::transpose_item_v4(ka->in[5] + ((size_t)l * 4 + bi) * 256 * 1024, 1024, 256, (bf16*)(dw + DW_BR) + (size_t)bi * 1024 * 256, 1, 0, scr, rr / 32, rr % 32, lane); continue; } r -= I_BR;
            if (r < I_WO) { pro::transpose_item_v4(ka->in[6] + (size_t)l * 1024 * 1024, 1024, 1024, (bf16*)(dw + DW_WO), 1, 0, scr, r / 32, r % 32, lane); continue; } r -= I_WO;
            if (r < I_WR) pro::transpose_item_v4(ka->in[9] + (size_t)l * 1024 * 256, 256, 1024, (bf16*)(dw + DW_WR), 1, 0, scr, r / 8, r % 8, lane);
            else { r -= I_WR; pro::transpose_item_v4<true>(ka->in[9] + (size_t)l * 1024 * 256, 256, 1024, (bf16*)(dw + DW_WR) + 256 * 1024, 1, 0, scr, r / 8, r % 8, lane); }
        }
        for (int m = gw; m < NTOK; m += NGW) {
            const float* xr = ka->in[0] + (size_t)m * DM + 8 * lane;
#pragma unroll
            for (int j = 0; j < 2; ++j) { const f32x4 a = *(const f32x4*)(xr + 512 * j), b = *(const f32x4*)(xr + 512 * j + 4);
                u32x4 w; w.x = pk2(a[0], a[1]); w.y = pk2(a[2], a[3]); w.z = pk2(b[0], b[1]); w.w = pk2(b[2], b[3]);
                *(u32x4*)(XB + (size_t)m * DM + 512 * j + 8 * lane) = w;
                int f0 = 0, f1 = 0; f0 = __builtin_amdgcn_cvt_pk_fp8_f32(a[0], a[1], f0, false); f0 = __builtin_amdgcn_cvt_pk_fp8_f32(a[2], a[3], f0, true);
                f1 = __builtin_amdgcn_cvt_pk_fp8_f32(b[0], b[1], f1, false); f1 = __builtin_amdgcn_cvt_pk_fp8_f32(b[2], b[3], f1, true);
                *(u32x2*)(ws + A_XB8 + (size_t)m * DM + 512 * j + 8 * lane) = (u32x2){(unsigned)f0, (unsigned)f1}; }
        }
    }
    SEAM(0);

    for (int l = 0; l < 2; ++l) {
        const int pb = 1 + 8 * l;
        unsigned char* dw = ws + WS_DENSE + (size_t)l * DENSE_L;
        unsigned* cnt = ctl + CW_CNT + l * 16384;
        const float lam_init = (l == 0) ? 0.2f : 0.35550906759096926f;
        bf16* const TB = (bf16*)(ws + A_TB);
#define TBS(s) (TB + (size_t)(s) * (16u << 20))

        if (PH_EN(0) && IN(pb + 0)) REPEAT(REP_A) {
            REP_SYNC;
            KARGS; OPAQUE_CG;
            { gm::GridOrder<1024> S; S.init(XB, dw + DW_WIN, NTOK / 256, 14, G, c);
              ep::InProj E{ws, ka->in[2] + 4 * l};
              gm::gemm_phase<1024, false, true>(lds, S, E); }
            { gm::GridOrder8<1024> S; S.init(ws + A_XB8, dw + DW_WG8, NTOK / 256, 16, G, c);
              ep::InGate E{ws + A_GATES};
              gm::gemm_phase<1024, false, true, ep::InGate, gm::GridOrder8<1024>, true, 0x7A7A7A7A>(lds, S, E); }
        }
        SEAM(pb + 0);

        if (PH_EN(1) && IN(pb + 1)) REPEAT(REP_B) {
            REP_SYNC;
            OPAQUE_CG; (void)c; (void)G;
            unsigned* qc = ctl + CW_Q + 64 * (l * 2 + 0) + 16 * rep;
            int task; QNEXT(qc, task);
            while (task < 144 + 2048) {
                QPREF(qc);
                if (task < 16) pre::cumsum_task(task, (const float*)(ws + WS_LOGF), (float*)(ws + WS_C2));
                else if (task < 144) pre::kmean_task(task - 16, TBS(4), (bf16*)(ws + WS_KMEAN));
                else { const int idx = task - 144; pre::d1_unit(idx & 31, 63 - (idx >> 5), TBS(12), (const bf16*)(ws + A_IDXK), (const float*)(ws + WS_IDXW), (float*)(ws + A_S), (unsigned long long*)(ws + A_MASK), lds, (rep + 1 < REP_B) ? BMASK : 7); }
                QTAKE(task);
            }
        }
        SEAM(pb + 1);

        if (PH_EN(2) && IN(pb + 2)) REPEAT(REP_C) {
            REP_SYNC;
            KARGS; OPAQUE_CG; (void)c; (void)G;
            unsigned* qc = ctl + CW_Q + 64 * (l * 2 + 1) + 16 * rep;
            att::Aux ax{ws, ka->in[3] + 128 * l, ka->in[4] + 64 * l, lam_init};
            int tk; QNEXT(qc, tk);
            while (tk < 4096 + 2056) {
                QPREF(qc);
                int u = -1, chunk = -1;
                if (tk < 6144) { const int g3 = tk / 3, ps = tk - 3 * g3; if (ps == 2) chunk = g3; else u = 2 * g3 + ps; } else chunk = 2048 + (tk - 6144);
                if (u >= 0) {
                    const int qb = 7 - (u >> 9), rem = u & 511, type = rem >> 7, bh = rem & 127, b = bh >> 2, h = bh & 3;
                    if (type == 0) att::attn_unit<1>(b, h, qb, ax, lds);
                    else if (type == 1) att::attn_unit<3>(b, h, qb, ax, lds);
                    else if (type == 2) att::attn_unit<2>(b, h, qb, ax, lds);
                    else att::attn_unit<0>(b, h, qb, ax, lds);
                } else
                    {
                        OPAQUE_IDS;
                        LAS float* scr = (LAS float*)(lds + wid * 16384);
#define XITEM(it_, SRC, LDW, KK, DST, RS, RO, KB, NB) \
            const int e##it_ = (it_) / 384, r##it_ = (it_) % 384, mat##it_ = r##it_ >> 7, sub##it_ = r##it_ & 127; \
            bf16* we##it_ = (bf16*)(ws + A_WEXP + (size_t)e##it_ * WEXP_E); \
            const float* SRC = mat##it_ < 2 ? ((e##it_ < 256) ? ka->in[11 + mat##it_] + ((size_t)l * 256 + e##it_) * 1024 * 256 : ka->in[14 + mat##it_] + (size_t)l * 1024 * 256) \
                                            : ((e##it_ < 256) ? ka->in[13] + ((size_t)l * 256 + e##it_) * 256 * 1024 : ka->in[16] + (size_t)l * 256 * 1024); \
            const int LDW = mat##it_ < 2 ? 256 : 1024, KK = mat##it_ < 2 ? 1024 : 256, RS = mat##it_ < 2 ? 2 : 1, RO = mat##it_ < 2 ? mat##it_ : 0; \
            bf16* DST = mat##it_ < 2 ? we##it_ : we##it_ + 512 * 1024; \
            const int KB = mat##it_ < 2 ? (sub##it_ >> 3) : (sub##it_ >> 5), NB = mat##it_ < 2 ? (sub##it_ & 7) : (sub##it_ & 31)
                        for (int pr = 0; pr < 3; ++pr) {
                            const int ita = chunk * 48 + wid * 6 + 2 * pr, itb = ita + 1;
                            XITEM(ita, srca, ldwa, kka, dsta, rsa, roa, kba, nba);
                            XITEM(itb, srcb, ldwb, kkb, dstb, rsb, rob, kbb, nbb);
                            f32x4 va[8], vb[8];
                            pro::transpose_load_v4(va, srca, ldwa, kba, nba, lane);
                            pro::transpose_load_v4(vb, srcb, ldwb, kbb, nbb, lane);
                            pro::transpose_finish_f8(va, kka, (unsigned char*)dsta, 32.0f, scr, kba, nba, lane, rsa, roa);
                            pro::transpose_finish_f8(vb, kkb, (unsigned char*)dstb, 32.0f, scr, kbb, nbb, lane, rsb, rob);
                        }
#undef XITEM
                    }
                QTAKE(tk);
            }
        }
        SEAM(pb + 2);

        if (PH_EN(3) && IN(pb + 3)) REPEAT(REP_D) {
            REP_SYNC;
            OPAQUE_IDS; KARGS; OPAQUE_CG;
            gm::MergeOrder S{{(const char*)(ws + A_O), (const char*)(ws + A_O + 32 * MiB), (const char*)(ws + A_O + 64 * MiB), (const char*)(ws + A_O + 96 * MiB)}, (const char*)(dw + DW_BR), G, c};
            ep::Merge E{(const unsigned char*)(ws + A_GATES), (bf16*)(ws + A_MERGED)};
            gm::gemm_phase<256, false, true>(lds, S, E);
        }
        if (IN(pb + 3) && IN(pb + 4)) { VM_WAIT(); __syncthreads(); }

        if (PH_EN(4) && IN(pb + 4)) REPEAT((l == 0) ? REP_E : 1) {
            REP_SYNC;
            OPAQUE_IDS; KARGS; OPAQUE_CG; (void)G;
            const bool dummy = (l == 0) && (rep + 1 < REP_E);
            unsigned* cnt = dummy ? ctl + CW_CNT + 2 * 16384 : ctl + CW_CNT + l * 16384;
            unsigned char* const ixb = dummy ? ws + AR + 1600 * MiB : ws;
            const int EPART = dummy ? EMASK : 15;
            const int pm = c;
            bf16* PRE = (bf16*)(ws + A_PRE); bf16* X1B = (bf16*)(ws + A_X1B); float* SC = (float*)(ws + A_SC);
            if (EPART & 1) { gm::PanelOrder<1024> S{(const char*)(ws + A_MERGED), (const char*)(dw + DW_WO), pm, 4}; ep::OutPre E{(const bf16*)X1B, PRE}; gm::gemm_phase<1024, false, false>(lds, S, E); }
            VM_WAIT(); __syncthreads();
            { int ln = lane, wv = wid; asm volatile("" : "+v"(ln), "+s"(wv));
            if (EPART & 2) for (int r = 0; r < 32; r += 4) { const size_t row = (size_t)pm * 256 + wv * 32 + r;
                f32x4 v[4][4]; float* of[4]; bf16* ob[4];
#pragma unroll
                for (int rr = 0; rr < 4; ++rr) { of[rr] = nullptr; ob[rr] = X1B + (row + rr) * DM;
#pragma unroll
                    for (int h = 0; h < 2; ++h) { const u32x4 pv = *(const u32x4*)(PRE + (row + rr) * DM + 512 * h + 8 * ln);
                        v[rr][2 * h] = (f32x4){bflo(pv.x), bfhi(pv.x), bflo(pv.y), bfhi(pv.y)}; v[rr][2 * h + 1] = (f32x4){bflo(pv.z), bfhi(pv.z), bflo(pv.w), bfhi(pv.w)}; } }
                rw::ln_store_n<4, true, true>(v, ka->in[7] + DM * l, ka->in[8] + DM * l, of, ob, ln, ROUTER_HILO ? (long)((A_X1L - A_X1B) / 2) : 0L, ws + A_X1F8, X1B); } }
            VM_WAIT(); __syncthreads();
            if (EPART & 4) { gm::RouterOrder S{(const char*)X1B, (const char*)(ws + A_X1L), (const char*)(dw + DW_WR), (const char*)(dw + DW_WR) + 256 * 1024 * 2, pm, ROUTER_HILO ? 3 : 1};
                ep::Router E{SC, ROUTER_HILO ? 2 : 0}; gm::gemm_phase<1024, false, false>(lds, S, E); }
            VM_WAIT(); __syncthreads();
            { int ln = lane, wv = wid, td = tid; asm volatile("" : "+v"(ln), "+s"(wv), "+v"(td));
            LAS unsigned* lcnt = (LAS unsigned*)(lds + LX_LCNT); LAS unsigned* lbase = (LAS unsigned*)(lds + LX_LBASE);
            int* eidx = (int*)(ixb + WS_EIDX); float* wsel = (float*)(ixb + WS_WSEL); int* slot = (int*)(ixb + WS_SLOT); int* rowl = dummy ? (int*)(ws + AR + 1700 * MiB) : (int*)(ws + A_ROWL);
            if (td < 256) { lcnt[td] = 0u; ((int*)(ws + WS_IDENT))[pm * 256 + td] = pm * 256 + td; }
            __syncthreads();
            if (EPART & 8) for (int r = 0; r < 32; r += 4) { const size_t t0 = (size_t)pm * 256 + wv * 32 + r;
                int e8[4][8]; float w8[4][8];
                rw::route_rows<4>(SC + t0 * 256, ka->in[10] + 256 * l, ln, e8, w8);
                if (ln < 32) { int me = 0; float mw = 0.f;
#pragma unroll
                    for (int rr = 0; rr < 4; ++rr)
#pragma unroll
                        for (int k = 0; k < 8; ++k) if (ln == rr * 8 + k) { me = e8[rr][k]; mw = w8[rr][k]; }
                    const unsigned ls = __hip_atomic_fetch_add(lcnt + me, 1u, __ATOMIC_RELAXED, __HIP_MEMORY_SCOPE_WORKGROUP);
                    eidx[t0 * 8 + ln] = me; wsel[t0 * 8 + ln] = mw; slot[t0 * 8 + ln] = (int)ls; } }
            VM_WAIT(); __syncthreads();
            if (td < 256) { const unsigned cc = lcnt[td]; lbase[td] = cc ? __hip_atomic_fetch_add(cnt + 64 * td, cc, RLX_AGENT) : 0u; }
            __syncthreads();
            if (EPART & 8) for (int idx = td; idx < 2048; idx += NTHREADS) { const size_t t = (size_t)pm * 256 + (idx >> 3); const int k = idx & 7;
                const int e = eidx[t * 8 + k]; const int s = slot[t * 8 + k] + (int)lbase[e]; slot[t * 8 + k] = s; rowl[(size_t)e * 65536 + s] = (int)t; } }
        }
        SEAM(pb + 4);

        if (PH_EN(5) && IN(pb + 5)) REPEAT(REP_F) {
            REP_SYNC;
            OPAQUE_CG;
            rw::expert_tables(cnt, TP, ST);
            gm::ExpertOrder<1024, 2, true, 1> S{TP, ST, (const int*)(ws + A_ROWL), (const int*)(ws + WS_IDENT), (const char*)(ws + A_X1F8), (const char*)(ws + A_WEXP), G, c};
            ep::E1 E{(bf16*)(ws + A_H)};
            gm::gemm_phase<1024, true, true, ep::E1, gm::ExpertOrder<1024, 2, true, 1>, true, 0x7A7A7A7A>(lds, S, E);
        }
        SEAM(pb + 5);

        if (PH_EN(6) && IN(pb + 6)) REPEAT(REP_G) {
            REP_SYNC;
            OPAQUE_CG;
            rw::expert_tables(cnt, TP, ST);
            gm::ExpertOrder<256, 4, false, 1> S{TP, ST, nullptr, nullptr, (const char*)(ws + A_H), (const char*)(ws + A_WEXP), G, c};
            ep::E2 E{(bf16*)(ws + A_Y), 0, ws + WS_DUMP};
            gm::gemm_phase<256, false, true, ep::E2, gm::ExpertOrder<256, 4, false, 1>, true, 0x7F7F7F7F, 0x7B7B7B7B, 8>(lds, S, E);
        }
        SEAM(pb + 6);

        if (PH_EN(7) && IN(pb + 7)) REPEAT(REP_H) {
            REP_SYNC;
            OPAQUE_IDS; KARGS; OPAQUE_CG;
            float* const hout = (rep + 1 < REP_H) ? (float*)(ws + A_WEXP) : ka->out;
            bf16* const hxb = (rep + 1 < REP_H) ? (bf16*)(ws + A_WEXP + 256 * MiB) : XB;
            rw::expert_tables(cnt, TP, ST);
            const int* eidx = (const int*)(ws + WS_EIDX); const float* wsel = (const float*)(ws + WS_WSEL); const int* slot = (const int*)(ws + WS_SLOT);
            const bf16* Y = (const bf16*)(ws + A_Y);
            const float* g2 = ka->in[17] + DM * l; const float* b2 = ka->in[18] + DM * l;
            const unsigned char* Y8 = (const unsigned char*)Y;
#define Y8ADD(dst, yv, wgt) do { _Pragma("unroll") for (int wi_ = 0; wi_ < 4; ++wi_) { const f32x2 lo_ = __builtin_amdgcn_cvt_pk_f32_fp8((int)(yv)[wi_], false), hi_ = __builtin_amdgcn_cvt_pk_f32_fp8((int)(yv)[wi_], true); \
                dst[wi_] = dst[wi_] + (f32x4){lo_[0], lo_[1], hi_[0], hi_[1]} * (wgt); } } while (0)
            for (int t0 = 2 * (c * NWAVES + wid); t0 < NTOK; t0 += 2 * G * NWAVES) {
                int d_[2]; float w_[2];
#pragma unroll
                for (int rr = 0; rr < 2; ++rr) { d_[rr] = 0; w_[rr] = 0.f;
                    if (lane < 8) { const size_t ix = (size_t)(t0 + rr) * 8 + lane; const int e_ = eidx[ix]; d_[rr] = ST[e_] + slot[ix]; w_[rr] = wsel[ix] * (1.0f / Y_SCALE); } }
                f32x4 v[2][4];
#pragma unroll
                for (int rr = 0; rr < 2; ++rr) { const bf16* xp = (const bf16*)(ws + A_X1B) + (size_t)(t0 + rr) * DM + 16 * lane;
                    const u32x4 ys = *(const u32x4*)(Y8 + ((size_t)ST[256] + t0 + rr) * DM + 16 * lane);
                    const u32x4 xa = *(const u32x4*)xp, xb2 = *(const u32x4*)(xp + 8);
                    v[rr][0] = (f32x4){bflo(xa.x), bfhi(xa.x), bflo(xa.y), bfhi(xa.y)} * ALPHA; v[rr][1] = (f32x4){bflo(xa.z), bfhi(xa.z), bflo(xa.w), bfhi(xa.w)} * ALPHA;
                    v[rr][2] = (f32x4){bflo(xb2.x), bfhi(xb2.x), bflo(xb2.y), bfhi(xb2.y)} * ALPHA; v[rr][3] = (f32x4){bflo(xb2.z), bfhi(xb2.z), bflo(xb2.w), bfhi(xb2.w)} * ALPHA;
                    Y8ADD(v[rr], ys, 1.0f / Y_SCALE); }
#pragma unroll
                for (int k = 0; k < 8; ++k)
#pragma unroll
                    for (int rr = 0; rr < 2; ++rr) { const int dk = __shfl(d_[rr], k); const float wk = __shfl(w_[rr], k);
                        const u32x4 y = *(const u32x4*)(Y8 + (size_t)dk * DM + 16 * lane); Y8ADD(v[rr], y, wk); }
                float s[2], s2[2];
#pragma unroll
                for (int rr = 0; rr < 2; ++rr) { s[rr] = 0.f;
#pragma unroll
                    for (int q = 0; q < 4; ++q) s[rr] += (v[rr][q][0] + v[rr][q][1]) + (v[rr][q][2] + v[rr][q][3]); }
#pragma unroll
                for (int o = 1; o < 64; o <<= 1)
#pragma unroll
                    for (int rr = 0; rr < 2; ++rr) s[rr] += __shfl_xor(s[rr], o);
#pragma unroll
                for (int rr = 0; rr < 2; ++rr) { const float mean = s[rr] * (1.0f / DM); s2[rr] = 0.f;
#pragma unroll
                    for (int q = 0; q < 4; ++q) { v[rr][q] = v[rr][q] - mean; s2[rr] += (v[rr][q][0] * v[rr][q][0] + v[rr][q][1] * v[rr][q][1]) + (v[rr][q][2] * v[rr][q][2] + v[rr][q][3] * v[rr][q][3]); } }
#pragma unroll
                for (int o = 1; o < 64; o <<= 1)
#pragma unroll
                    for (int rr = 0; rr < 2; ++rr) s2[rr] += __shfl_xor(s2[rr], o);
#pragma unroll
                for (int rr = 0; rr < 2; ++rr) { const float rstd = rsqrtf(s2[rr] * (1.0f / DM) + LN_EPS);
                    float* op = hout + (size_t)(t0 + rr) * DM + 16 * lane; f32x4 ov[4];
#pragma unroll
                    for (int i = 0; i < 4; ++i) { ov[i] = v[rr][i] * rstd * *(const f32x4*)(g2 + 16 * lane + 4 * i) + *(const f32x4*)(b2 + 16 * lane + 4 * i); if (l == 1) *(f32x4*)(op + 4 * i) = ov[i]; }
                    if (l == 1) continue;
                    u32x4 wa, wb; wa.x = pk2(ov[0][0], ov[0][1]); wa.y = pk2(ov[0][2], ov[0][3]); wa.z = pk2(ov[1][0], ov[1][1]); wa.w = pk2(ov[1][2], ov[1][3]);
                    wb.x = pk2(ov[2][0], ov[2][1]); wb.y = pk2(ov[2][2], ov[2][3]); wb.z = pk2(ov[3][0], ov[3][1]); wb.w = pk2(ov[3][2], ov[3][3]);
                    bf16* xb = hxb + (size_t)(t0 + rr) * DM + 16 * lane; *(u32x4*)xb = wa; *(u32x4*)(xb + 8) = wb;
                    int f8[4];
#pragma unroll
                    for (int i = 0; i < 4; ++i) { int t = 0; t = __builtin_amdgcn_cvt_pk_fp8_f32(ov[i][0], ov[i][1], t, false); t = __builtin_amdgcn_cvt_pk_fp8_f32(ov[i][2], ov[i][3], t, true); f8[i] = t; }
                    *(u32x4*)(ws + A_XB8 + (size_t)(t0 + rr) * DM + 16 * lane) = (u32x4){(unsigned)f8[0], (unsigned)f8[1], (unsigned)f8[2], (unsigned)f8[3]}; }
            }
#undef Y8ADD
        }
        SEAM(pb + 7);
#undef TBS
    }
#undef IN
#undef SEAM
#undef QNEXT
}

extern "C" void kernel_launch(void* const* d_in, const int* in_sizes, int n_in, void* d_out, int out_size, void* d_ws, size_t ws_size, hipStream_t stream) {
    static int grid = 0;
    if (grid == 0) {
        if (n_in != 19 || out_size != NTOK * DM || ws_size < WS_END) { fprintf(stderr, "kernel_launch: unexpected shapes: n_in %d out %d ws %zu (need %zu)\n", n_in, out_size, ws_size, (size_t)WS_END); grid = -1; return; }
        int dev = 0, cus = 0;
        if (hipGetDevice(&dev) != hipSuccess || hipDeviceGetAttribute(&cus, hipDeviceAttributeMultiprocessorCount, dev) != hipSuccess) { grid = -1; return; }
        if (hipFuncSetAttribute((const void*)mk_fwd, hipFuncAttributeMaxDynamicSharedMemorySize, LDS_BYTES) != hipSuccess) { fprintf(stderr, "kernel_launch: hipFuncSetAttribute failed\n"); grid = -1; return; }
        int per_cu = 0;
        if (hipOccupancyMaxActiveBlocksPerMultiprocessor(&per_cu, (const void*)mk_fwd, NTHREADS, LDS_BYTES) != hipSuccess || per_cu < 1) fprintf(stderr, "kernel_launch: occupancy query says %d\n", per_cu);
        (void)hipGetLastError();
        if (cus != 256) { fprintf(stderr, "kernel_launch: built for 256 CUs, device has %d\n", cus); grid = -1; return; }
        grid = 256;
    }
    if (grid < 0) return;
    (void)hipMemsetAsync((char*)d_ws + WS_CTL, 0, CTL_BYTES, stream);
    Args a{};
    for (int i = 0; i < 19; ++i) a.in[i] = (const float*)d_in[i];
    a.out = (float*)d_out; a.ws = (unsigned char*)d_ws;
#if MK_ONE_LAUNCH
    a.ph_lo = 0; a.ph_hi = NPHASE;
    hipLaunchKernelGGL(mk_fwd, dim3(grid), dim3(NTHREADS), LDS_BYTES, stream, a);
#else
    for (int p = 0; p < NPHASE; ++p) { a.ph_lo = p; a.ph_hi = p + 1; hipLaunchKernelGGL(mk_fwd, dim3(grid), dim3(NTHREADS), LDS_BYTES, stream, a); }
#endif
}
```
